# Optimizing an MI355X kernel written in HIP

```python
import math
import jax, jax.numpy as jnp
from jax import lax
import numpy as np

D_MODEL = 1024
BATCH = 8
SEQ = 8192
DEPTH = 1
DEC_BATCH = 8
DEC_SEQ = 2048
PAST_LEN = 128

D_SSM = D_MODEL // 2
SSM_GROUP = 16
N_SSM_GROUPS = D_SSM // SSM_GROUP
SSM_STATE = 64
D_HYENA = D_MODEL - D_SSM
HYENA_ORDER = 2
HYENA_SHORT = 3
HYENA_BANDS = 8
HYENA_POS_DIM = 1 + 2 * HYENA_BANDS
HYENA_FILTER_HIDDEN = 64
HYENA_TIME_SCALE = 4096.0
HYENA_MAX_PERIOD = 10000.0
N_FILTERS = HYENA_ORDER * 2 * D_HYENA
D_IN = D_SSM + (HYENA_ORDER + 1) * D_HYENA
D_FF = 128 * math.ceil(8 * D_MODEL / 3 / 128)
LN_EPS = 1e-5
RMS_EPS = 1e-6
FILTER_EPS = 1e-6
DEEPNORM_ALPHA = (2.0 * DEPTH) ** 0.25
DEEPNORM_BETA = (8.0 * DEPTH) ** -0.25

kernel_name = "hybrid_s5_hyena_macaron_encoder"

F32 = jnp.float32


def _layer_norm(x, g, b):
    xf = x.astype(F32)
    mu = jnp.mean(xf, axis=-1, keepdims=True)
    xc = xf - mu
    var = jnp.mean(xc * xc, axis=-1, keepdims=True)
    return (xc * lax.rsqrt(var + LN_EPS) * g.astype(F32) + b.astype(F32)).astype(x.dtype)


def _rms_norm(x, g, dtype):
    xf = x.astype(F32)
    ms = jnp.mean(xf * xf, axis=-1, keepdims=True)
    return (xf * lax.rsqrt(ms + RMS_EPS) * g.astype(F32)).astype(dtype)


def _swiglu(x, w_gate, w_up, w_down):
    return (jax.nn.silu(x @ w_gate) * (x @ w_up)) @ w_down


def _ffn_sublayer(x, w_gate, w_up, w_down, ln_g, ln_b):
    return _layer_norm(DEEPNORM_ALPHA * x + 0.5 * _swiglu(x, w_gate, w_up, w_down), ln_g, ln_b)


def _short_conv(x, w, b):
    L = x.shape[1]
    pad = HYENA_SHORT // 2
    xp = jnp.pad(x, ((0, 0), (pad, pad), (0, 0)))
    y = b
    for j in range(HYENA_SHORT):
        y = y + xp[:, j:j + L] * w[j]
    return y


def _complex_linear_combine(e1, e2):
    a1r, a1i, b1r, b1i = e1
    a2r, a2i, b2r, b2i = e2
    ar = a2r * a1r - a2i * a1i
    ai = a2r * a1i + a2i * a1r
    br = a2r * b1r - a2i * b1i + b2r
    bi = a2r * b1i + a2i * b1r + b2i
    return ar, ai, br, bi


def _s5_discretize(lam_re, lam_im, log_step, b_re, b_im):
    step = jnp.exp(log_step)[:, None]
    mag = jnp.exp(lam_re * step)
    ar = mag * jnp.cos(lam_im * step)
    ai = mag * jnp.sin(lam_im * step)
    nr = ar - 1.0
    ni = ai
    den = lam_re * lam_re + lam_im * lam_im
    qr = (nr * lam_re + ni * lam_im) / den
    qi = (ni * lam_re - nr * lam_im) / den
    bbr = qr[..., None] * b_re - qi[..., None] * b_im
    bbi = qr[..., None] * b_im + qi[..., None] * b_re
    return ar, ai, bbr, bbi


def _s5_scan(u, ar, ai, bbr, bbi, c_re, c_im, reverse):
    L = u.shape[0]
    bur = jnp.einsum('lgh,gph->lgp', u, bbr)
    bui = jnp.einsum('lgh,gph->lgp', u, bbi)
    a_r = jnp.broadcast_to(ar, (L,) + ar.shape)
    a_i = jnp.broadcast_to(ai, (L,) + ai.shape)
    _, _, hr, hi = lax.associative_scan(_complex_linear_combine, (a_r, a_i, bur, bui),
                                        reverse=reverse, axis=0)
    return jnp.einsum('lgp,ghp->lgh', hr, c_re) - jnp.einsum('lgp,ghp->lgh', hi, c_im)


def _s5_mixer(u, lam_re, lam_im, log_step, b_re, b_im, c_re, c_im, d):
    nb, L, _ = u.shape
    ug = u.astype(F32).reshape(nb, L, N_SSM_GROUPS, SSM_GROUP)
    lam_re, lam_im, log_step = lam_re.astype(F32), lam_im.astype(F32), log_step.astype(F32)
    b_re, b_im, c_re, c_im = b_re.astype(F32), b_im.astype(F32), c_re.astype(F32), c_im.astype(F32)
    d = d.astype(F32)
    fwd = _s5_discretize(lam_re[0], lam_im[0], log_step[0], b_re[0], b_im[0])
    bwd = _s5_discretize(lam_re[1], lam_im[1], log_step[1], b_re[1], b_im[1])

    def one_sequence(us):
        yf = _s5_scan(us, *fwd, c_re[0], c_im[0], False)
        yb = _s5_scan(us, *bwd, c_re[1], c_im[1], True)
        return yf + yb + d * us

    y = lax.map(one_sequence, ug)
    return y.reshape(nb, L, D_SSM)


def _hyena_filter_spectrum(L, w1, b1, w2, b2, w3, sin_freq, log_decay):
    w1, b1, w2, b2, w3 = (a.astype(F32) for a in (w1, b1, w2, b2, w3))
    sin_freq, log_decay = sin_freq.astype(F32), log_decay.astype(F32)
    t = jnp.arange(L, dtype=F32)
    t_lin = t / HYENA_TIME_SCALE
    omega = jnp.exp(-math.log(HYENA_MAX_PERIOD) * jnp.arange(HYENA_BANDS, dtype=F32) / HYENA_BANDS)
    ang = t[:, None] * omega[None, :]
    feats = jnp.concatenate([t_lin[:, None], jnp.sin(ang), jnp.cos(ang)], axis=-1)
    hdn = jnp.sin(sin_freq[0] * (feats @ w1 + b1))
    hdn = jnp.sin(sin_freq[1] * (hdn @ w2 + b2))
    filt = (hdn @ w3) * jnp.exp(-t_lin[:, None] * jnp.exp(log_decay)[None, :])
    filt = filt.reshape(L, HYENA_ORDER, 2, D_HYENA)
    fwd = filt[:, :, 0]
    bwd = filt[:, :, 1]
    k = jnp.concatenate([fwd, jnp.zeros((1, HYENA_ORDER, D_HYENA), F32), bwd[:0:-1]], axis=0)
    k = k / (jnp.sum(jnp.abs(k), axis=0, keepdims=True) + FILTER_EPS)
    return jnp.fft.rfft(k, axis=0)


def _hyena_mixer(v, gates, k_f, bias):
    L = v.shape[1]
    n = 2 * L
    z = v
    for o in range(HYENA_ORDER):
        zf = jnp.fft.rfft(z, n=n, axis=1)
        y = jnp.fft.irfft(zf * k_f[None, :, o], n=n, axis=1)[:, :L]
        z = gates[o] * (y + bias[o] * z)
    return z


def _mixing_sublayer(h, w_in,
                     ssm_lam_re, ssm_lam_im, ssm_log_step, ssm_b_re, ssm_b_im, ssm_c_re, ssm_c_im,
                     ssm_d, ssm_glu_w, ssm_glu_b, ssm_norm_g,
                     hy_short_w, hy_short_b, hy_filt_w1, hy_filt_b1, hy_filt_w2, hy_filt_b2,
                     hy_filt_w3, hy_sin_freq, hy_log_decay, hy_bias, hy_norm_g, w_out):
    proj = h @ w_in
    u = proj[..., :D_SSM]
    hy = _short_conv(proj[..., D_SSM:], hy_short_w, hy_short_b).astype(F32)
    v = hy[..., :D_HYENA]
    gates = [hy[..., D_HYENA * (o + 1):D_HYENA * (o + 2)] for o in range(HYENA_ORDER)]

    y_ssm = _s5_mixer(u, ssm_lam_re, ssm_lam_im, ssm_log_step, ssm_b_re, ssm_b_im,
                      ssm_c_re, ssm_c_im, ssm_d)
    g = jax.nn.gelu(y_ssm)
    y_ssm = g * jax.nn.sigmoid(g @ ssm_glu_w.astype(F32) + ssm_glu_b.astype(F32))

    k_f = _hyena_filter_spectrum(h.shape[1], hy_filt_w1, hy_filt_b1, hy_filt_w2, hy_filt_b2,
                                 hy_filt_w3, hy_sin_freq, hy_log_decay)
    y_hy = _hyena_mixer(v, gates, k_f, hy_bias.astype(F32))

    mixed = jnp.concatenate([_rms_norm(y_ssm, ssm_norm_g, h.dtype),
                             _rms_norm(y_hy, hy_norm_g, h.dtype)], axis=-1)
    return mixed @ w_out


def _run_trunk(x, ffn1_w_gate, ffn1_w_up, ffn1_w_down, ln1_g, ln1_b, w_in,
               ssm_lam_re, ssm_lam_im, ssm_log_step, ssm_b_re, ssm_b_im, ssm_c_re, ssm_c_im,
               ssm_d, ssm_glu_w, ssm_glu_b, ssm_norm_g,
               hy_short_w, hy_short_b, hy_filt_w1, hy_filt_b1, hy_filt_w2, hy_filt_b2, hy_filt_w3,
               hy_sin_freq, hy_log_decay, hy_bias, hy_norm_g, w_out, ln2_g, ln2_b,
               ffn2_w_gate, ffn2_w_up, ffn2_w_down, ln3_g, ln3_b):
    for l in range(DEPTH):
        x = _ffn_sublayer(x, ffn1_w_gate[l], ffn1_w_up[l], ffn1_w_down[l], ln1_g[l], ln1_b[l])
        mix = _mixing_sublayer(x, w_in[l],
                               ssm_lam_re[l], ssm_lam_im[l], ssm_log_step[l], ssm_b_re[l], ssm_b_im[l],
                               ssm_c_re[l], ssm_c_im[l], ssm_d[l], ssm_glu_w[l], ssm_glu_b[l], ssm_norm_g[l],
                               hy_short_w[l], hy_short_b[l], hy_filt_w1[l], hy_filt_b1[l], hy_filt_w2[l],
                               hy_filt_b2[l], hy_filt_w3[l], hy_sin_freq[l], hy_log_decay[l], hy_bias[l],
                               hy_norm_g[l], w_out[l])
        x = _layer_norm(DEEPNORM_ALPHA * x + mix, ln2_g[l], ln2_b[l])
        x = _ffn_sublayer(x, ffn2_w_gate[l], ffn2_w_up[l], ffn2_w_down[l], ln3_g[l], ln3_b[l])
    return x


def setup_inputs(seed: int = 0) -> dict:
    key = jax.random.key(seed)
    ks = iter(jax.random.split(key, 48))
    nrm = lambda shape, scale: scale * jax.random.normal(next(ks), shape, F32)
    G, H, P = N_SSM_GROUPS, SSM_GROUP, SSM_STATE
    Dp = DEPTH

    x_prompt = jax.random.normal(next(ks), (BATCH, SEQ, D_MODEL), F32)
    x_sample = jax.random.normal(next(ks), (DEC_BATCH, DEC_SEQ, D_MODEL), F32)

    ffn1_w_gate = nrm((Dp, D_MODEL, D_FF), D_MODEL ** -0.5)
    ffn1_w_up = nrm((Dp, D_MODEL, D_FF), D_MODEL ** -0.5)
    ffn1_w_down = nrm((Dp, D_FF, D_MODEL), DEEPNORM_BETA * D_FF ** -0.5)
    ln1_g = 1.0 + nrm((Dp, D_MODEL), 0.02)
    ln1_b = nrm((Dp, D_MODEL), 0.02)

    w_in = nrm((Dp, D_MODEL, D_IN), D_MODEL ** -0.5)

    ssm_lam_re = -0.5 + nrm((Dp, 2, G, P), 0.01)
    ssm_lam_im = jnp.pi * jnp.arange(P, dtype=F32) + nrm((Dp, 2, G, P), 0.01)
    ssm_log_step = jax.random.uniform(next(ks), (Dp, 2, G), F32, math.log(1e-3), math.log(1e-1))
    ssm_b_re = nrm((Dp, 2, G, P, H), (2.0 * H) ** -0.5)
    ssm_b_im = nrm((Dp, 2, G, P, H), (2.0 * H) ** -0.5)
    ssm_c_re = nrm((Dp, 2, G, H, P), (2.0 * P) ** -0.5)
    ssm_c_im = nrm((Dp, 2, G, H, P), (2.0 * P) ** -0.5)
    ssm_d = nrm((Dp, G, H), 1.0)
    ssm_glu_w = nrm((Dp, D_SSM, D_SSM), D_SSM ** -0.5)
    ssm_glu_b = nrm((Dp, D_SSM), 0.02)
    ssm_norm_g = 1.0 + nrm((Dp, D_SSM), 0.02)

    hy_short_w = nrm((Dp, HYENA_SHORT, (HYENA_ORDER + 1) * D_HYENA), HYENA_SHORT ** -0.5)
    hy_short_b = nrm((Dp, (HYENA_ORDER + 1) * D_HYENA), 0.02)
    hy_filt_w1 = nrm((Dp, HYENA_POS_DIM, HYENA_FILTER_HIDDEN), HYENA_POS_DIM ** -0.5)
    hy_filt_b1 = nrm((Dp, HYENA_FILTER_HIDDEN), 0.1)
    hy_filt_w2 = nrm((Dp, HYENA_FILTER_HIDDEN, HYENA_FILTER_HIDDEN), HYENA_FILTER_HIDDEN ** -0.5)
    hy_filt_b2 = nrm((Dp, HYENA_FILTER_HIDDEN), 0.1)
    hy_filt_w3 = nrm((Dp, HYENA_FILTER_HIDDEN, N_FILTERS), HYENA_FILTER_HIDDEN ** -0.5)
    hy_sin_freq = 1.0 + nrm((Dp, 2, HYENA_FILTER_HIDDEN), 0.1)
    fast, slow = math.log(abs(math.log(1e-2)) / 0.3), math.log(abs(math.log(1e-2)) / 1.5)
    base_decay = jnp.tile(jnp.linspace(fast, slow, D_HYENA, dtype=F32), HYENA_ORDER * 2)
    hy_log_decay = base_decay + nrm((Dp, N_FILTERS), 0.01)
    hy_bias = nrm((Dp, HYENA_ORDER, D_HYENA), 1.0)
    hy_norm_g = 1.0 + nrm((Dp, D_HYENA), 0.02)

    w_out = nrm((Dp, D_MODEL, D_MODEL), DEEPNORM_BETA * D_MODEL ** -0.5)
    ln2_g = 1.0 + nrm((Dp, D_MODEL), 0.02)
    ln2_b = nrm((Dp, D_MODEL), 0.02)

    ffn2_w_gate = nrm((Dp, D_MODEL, D_FF), D_MODEL ** -0.5)
    ffn2_w_up = nrm((Dp, D_MODEL, D_FF), D_MODEL ** -0.5)
    ffn2_w_down = nrm((Dp, D_FF, D_MODEL), DEEPNORM_BETA * D_FF ** -0.5)
    ln3_g = 1.0 + nrm((Dp, D_MODEL), 0.02)
    ln3_b = nrm((Dp, D_MODEL), 0.02)

    return {
        "x_prompt": x_prompt, "x_sample": x_sample,
        "ffn1_w_gate": ffn1_w_gate, "ffn1_w_up": ffn1_w_up, "ffn1_w_down": ffn1_w_down,
        "ln1_g": ln1_g, "ln1_b": ln1_b, "w_in": w_in,
        "ssm_lam_re": ssm_lam_re, "ssm_lam_im": ssm_lam_im, "ssm_log_step": ssm_log_step,
        "ssm_b_re": ssm_b_re, "ssm_b_im": ssm_b_im, "ssm_c_re": ssm_c_re, "ssm_c_im": ssm_c_im,
        "ssm_d": ssm_d, "ssm_glu_w": ssm_glu_w, "ssm_glu_b": ssm_glu_b, "ssm_norm_g": ssm_norm_g,
        "hy_short_w": hy_short_w, "hy_short_b": hy_short_b,
        "hy_filt_w1": hy_filt_w1, "hy_filt_b1": hy_filt_b1, "hy_filt_w2": hy_filt_w2,
        "hy_filt_b2": hy_filt_b2, "hy_filt_w3": hy_filt_w3, "hy_sin_freq": hy_sin_freq,
        "hy_log_decay": hy_log_decay, "hy_bias": hy_bias, "hy_norm_g": hy_norm_g,
        "w_out": w_out, "ln2_g": ln2_g, "ln2_b": ln2_b,
        "ffn2_w_gate": ffn2_w_gate, "ffn2_w_up": ffn2_w_up, "ffn2_w_down": ffn2_w_down,
        "ln3_g": ln3_g, "ln3_b": ln3_b,
    }


def reference(x_prompt, x_sample, ffn1_w_gate, ffn1_w_up, ffn1_w_down, ln1_g, ln1_b, w_in,
              ssm_lam_re, ssm_lam_im, ssm_log_step, ssm_b_re, ssm_b_im, ssm_c_re, ssm_c_im,
              ssm_d, ssm_glu_w, ssm_glu_b, ssm_norm_g,
              hy_short_w, hy_short_b, hy_filt_w1, hy_filt_b1, hy_filt_w2, hy_filt_b2, hy_filt_w3,
              hy_sin_freq, hy_log_decay, hy_bias, hy_norm_g, w_out, ln2_g, ln2_b,
              ffn2_w_gate, ffn2_w_up, ffn2_w_down, ln3_g, ln3_b):
    y_prompt = _run_trunk(x_prompt, ffn1_w_gate, ffn1_w_up, ffn1_w_down, ln1_g, ln1_b, w_in,
                          ssm_lam_re, ssm_lam_im, ssm_log_step, ssm_b_re, ssm_b_im, ssm_c_re, ssm_c_im,
                          ssm_d, ssm_glu_w, ssm_glu_b, ssm_norm_g,
                          hy_short_w, hy_short_b, hy_filt_w1, hy_filt_b1, hy_filt_w2, hy_filt_b2, hy_filt_w3,
                          hy_sin_freq, hy_log_decay, hy_bias, hy_norm_g, w_out, ln2_g, ln2_b,
                          ffn2_w_gate, ffn2_w_up, ffn2_w_down, ln3_g, ln3_b)
    y_sample = _run_trunk(x_sample, ffn1_w_gate, ffn1_w_up, ffn1_w_down, ln1_g, ln1_b, w_in,
                          ssm_lam_re, ssm_lam_im, ssm_log_step, ssm_b_re, ssm_b_im, ssm_c_re, ssm_c_im,
                          ssm_d, ssm_glu_w, ssm_glu_b, ssm_norm_g,
                          hy_short_w, hy_short_b, hy_filt_w1, hy_filt_b1, hy_filt_w2, hy_filt_b2, hy_filt_w3,
                          hy_sin_freq, hy_log_decay, hy_bias, hy_norm_g, w_out, ln2_g, ln2_b,
                          ffn2_w_gate, ffn2_w_up, ffn2_w_down, ln3_g, ln3_b)
    return (y_prompt, y_sample)
```

```cpp
#include <hip/hip_runtime.h>
#include <hip/hip_cooperative_groups.h>
#include <cstdio>
#include <cstdint>
namespace cg = cooperative_groups;

#define LAS __attribute__((address_space(3)))
typedef unsigned short bf16_t;
typedef short bf16x8 __attribute__((ext_vector_type(8)));
typedef float f32x4 __attribute__((ext_vector_type(4)));
typedef float f32x2 __attribute__((ext_vector_type(2)));
typedef float f32x16 __attribute__((ext_vector_type(16)));
typedef unsigned u32x4 __attribute__((ext_vector_type(4)));
typedef unsigned u32x2 __attribute__((ext_vector_type(2)));
struct __attribute__((packed, aligned(4))) U4A4 { unsigned x, y, z, w; };

constexpr int MP = 65536, MS = 16384, MT = 81920, DM = 1024, FF = 2816, DIN = 2048;
constexpr int LP = 8192, LS = 2048;
constexpr int NCHUNK = MT / 16;
constexpr float ALPHA = 1.189207115002721f;
constexpr float LN_EPS = 1e-5f, RMS_EPS = 1e-6f, FILTER_EPS = 1e-6f;
constexpr int NTHREADS = 512, NWAVES = 8;
constexpr int LDS_BYTES = 147456;

constexpr size_t MiB = 1u << 20;
constexpr size_t WS_WGU1 = 0 * MiB, WS_WD1 = 12 * MiB, WS_WIN = 18 * MiB, WS_WGLU = 22 * MiB, WS_WOUT = 23 * MiB, WS_WGU2 = 25 * MiB, WS_WD2 = 36 * MiB;
constexpr size_t WS_WEND = 42 * MiB, WS_WMAT = 46 * MiB, WS_SCAN = 54 * MiB, WS_PART = 55 * MiB  ;
constexpr size_t WS_XB = 58 * MiB;
constexpr size_t WS_H = 218 * MiB;
constexpr size_t WS_YHY = 658 * MiB;
constexpr size_t WS_FRAW = 738 * MiB;
constexpr size_t WS_FP = 802 * MiB;
constexpr size_t WS_FS = 868 * MiB;
constexpr size_t WS_END = 886 * MiB;

__device__ __forceinline__ unsigned f2bf(float f) { unsigned u = __builtin_bit_cast(unsigned, f); return (u + 0x7fffu + ((u >> 16) & 1u)) >> 16; }
__device__ __forceinline__ unsigned pk2(float lo, float hi) { return f2bf(lo) | (f2bf(hi) << 16); }
__device__ __forceinline__ float bf_lo(unsigned u) { return __builtin_bit_cast(float, u << 16); }
__device__ __forceinline__ float bf_hi(unsigned u) { return __builtin_bit_cast(float, u & 0xffff0000u); }
__device__ __forceinline__ float bf2f(bf16_t h) { return __builtin_bit_cast(float, (unsigned)h << 16); }
__device__ __forceinline__ float wave_sum(float v) {
#pragma unroll
    for (int o = 1; o < 64; o <<= 1) v += __shfl_xor(v, o);
    return v;
}
#define LDS_WAIT() asm volatile("s_waitcnt lgkmcnt(0)" ::: "memory")

namespace pg8 {
constexpr int BM = 256, BK = 64, HALF = 128, HTB = HALF * BK * 2, NXCD = 8, WGM = 8;
__device__ __forceinline__ int lds_byte(int r, int c) { const int st = (r >> 4) * 2 + (c >> 5), rr = r & 15, cc = c & 31, ob = rr * 64 + cc * 2; return st * 1024 + (ob ^ (((ob >> 9) & 1) << 5)); }
__device__ __forceinline__ void stage_rc(int b, int& R, int& C) { const int st = b / 1024, sb = b % 1024, swz = sb ^ (((sb >> 9) & 1) << 5); R = (st >> 1) * 16 + swz / 64; C = (st & 1) * 32 + (swz % 64) / 2; }
__device__ __forceinline__ int perm32(int rho) { const int n = rho >> 4, i = rho & 15; return 8 * (i >> 2) + 4 * n + (i & 3); }
struct Unit { int pm, pn; };
struct Gemm { const bf16_t* A; const bf16_t* Bt; int K, lda, ldb; };
struct StaticOrder {
    int nM, nN, nwg, G, c;
    __device__ void init(int M, int N, int G_, int c_) { nM = M / BM; nN = N / BM; nwg = nM * nN; G = G_; c = c_; }
    __device__ bool next(int i, Unit& u) const {
        const long L = (long)i * G + c; if (L >= nwg) return false;
        int wgid = (int)L; { const int q = nwg / NXCD, r = nwg % NXCD, xcd = wgid % NXCD, off = wgid / NXCD; wgid = (xcd < r ? xcd * (q + 1) : r * (q + 1) + (xcd - r) * q) + off; }
        const int nig = WGM * nN, gid = wgid / nig, fm = gid * WGM, gsz = (nM - fm) < WGM ? (nM - fm) : WGM;
        u.pm = fm + ((wgid % nig) % gsz); u.pn = (wgid % nig) / gsz; return true;
    }
};
struct GroupOrder {
    int G, c;
    __device__ bool next(int i, Unit& u) const { const int L = i * G + c; if (L >= 640) return false; u.pm = L; u.pn = L / 20; return true; }
};

template <class Epi, class Sched, bool ALIGN_EPI>
__device__ __forceinline__ void gemm_phase(LAS unsigned char* lds, const Gemm g, const Sched& S, const Epi& E) {
    int tid_ = threadIdx.x; asm volatile("" : "+v"(tid_));
    const int tid = tid_, wid = __builtin_amdgcn_readfirstlane(tid >> 6), lane = tid & 63, wr = wid >> 2, wc = wid & 3, fr = lane & 15, fq = lane >> 4;
    const int K = g.K, nt = K / BK;
    unsigned voffA[2], voffB[2];
#pragma unroll
    for (int i = 0; i < 2; ++i) { int R, C; stage_rc(tid * 16 + i * 8192, R, C); const int Rb = (R & ~31) + perm32(R & 31);
        voffA[i] = (unsigned)(R * g.lda + C) * 2u; voffB[i] = (unsigned)(Rb * g.ldb + C) * 2u; }
    const size_t kstep = (size_t)(BK * 2);
    const size_t hstepA = (size_t)HALF * g.lda * 2, hstepB = (size_t)HALF * g.ldb * 2;
    const size_t tstepA = 2 * hstepA, tstepB = 2 * hstepB;
    const unsigned ldsw = (unsigned)wid * 1024u;
    const int aoff = lds_byte(wr * 64 + fr, fq * 8), boff = lds_byte(wc * 32 + fr, fq * 8);
#define PG8_SA(b, h) (((b) * 2 + (h)) * HTB)
#define PG8_SB(b, h) ((4 + (b) * 2 + (h)) * HTB)
#define PG8_STAGE(bufoff, gbase, voff) do { _Pragma("unroll") for (int _i = 0; _i < 2; ++_i) \
        __builtin_amdgcn_global_load_lds((const unsigned*)((const char*)(gbase) + (voff)[_i]), (LAS unsigned*)(lds + (bufoff) + ldsw + _i * 8192), 16, 0, 0); } while (0)
#define PG8_LDA(dst, b, h) do { _Pragma("unroll") for (int m = 0; m < 4; ++m) _Pragma("unroll") for (int k = 0; k < 2; ++k) dst[m][k] = *(const LAS bf16x8*)(lds + PG8_SA(b, h) + aoff + m * 2048 + k * 1024); } while (0)
#define PG8_LDB(dst, b, h) do { _Pragma("unroll") for (int n = 0; n < 2; ++n) _Pragma("unroll") for (int k = 0; k < 2; ++k) dst[n][k] = *(const LAS bf16x8*)(lds + PG8_SB(b, h) + boff + n * 2048 + k * 1024); } while (0)
#define PG8_MMA(ai, bj, At, Bt) do { __builtin_amdgcn_s_setprio(1); _Pragma("unroll") for (int m = 0; m < 4; ++m) _Pragma("unroll") for (int n = 0; n < 2; ++n) _Pragma("unroll") for (int k = 0; k < 2; ++k) \
        acc[ai][bj][m][n] = __builtin_amdgcn_mfma_f32_16x16x32_bf16(Bt[n][k], At[m][k], acc[ai][bj][m][n], 0, 0, 0); __builtin_amdgcn_s_setprio(0); } while (0)
#define PG8_WAIT_V(n) asm volatile("s_waitcnt vmcnt(" #n ")" ::: "memory")
#define PG8_WAIT_L(n) asm volatile("s_waitcnt lgkmcnt(" #n ")" ::: "memory")
#define PG8_BAR __builtin_amdgcn_s_barrier()
#define PG8_SCHED __builtin_amdgcn_sched_barrier(0)
    Unit cur, nxt; int ui = 0;
    if (!S.next(0, cur)) return;
    f32x4 acc[2][2][4][2];
#pragma unroll
    for (int a = 0; a < 2; ++a)
#pragma unroll
        for (int b = 0; b < 2; ++b)
#pragma unroll
            for (int m = 0; m < 4; ++m)
#pragma unroll
                for (int n = 0; n < 2; ++n) acc[a][b][m][n] = (f32x4){0.f, 0.f, 0.f, 0.f};
    bf16x8 At[4][2], B0[2][2], B1[2][2];
    const char* cA = (const char*)g.A + (size_t)cur.pm * tstepA; const char* cB = (const char*)g.Bt + (size_t)cur.pn * tstepB;
    PG8_STAGE(PG8_SB(0, 0), cB, voffB); PG8_STAGE(PG8_SB(0, 1), cB + hstepB, voffB); PG8_STAGE(PG8_SA(0, 0), cA, voffA); PG8_STAGE(PG8_SA(0, 1), cA + hstepA, voffA);
    if (wr == 1) PG8_BAR;
    PG8_WAIT_V(2); PG8_BAR;
    PG8_STAGE(PG8_SB(1, 0), cB + kstep, voffB); PG8_STAGE(PG8_SA(1, 0), cA + kstep, voffA); PG8_STAGE(PG8_SB(1, 1), cB + hstepB + kstep, voffB);
    PG8_WAIT_V(6); PG8_BAR;
    for (;;) {
        const bool has_next = S.next(ui + 1, nxt);
        const char* nA = has_next ? (const char*)g.A + (size_t)nxt.pm * tstepA : cA; const char* nB = has_next ? (const char*)g.Bt + (size_t)nxt.pn * tstepB : cB;
        for (int t = 0; t < nt; t += 2) {
            const bool last = (t == nt - 2);
            const char* a1 = cA + (size_t)(t + 1) * kstep;
            const char* a2 = last ? nA : cA + (size_t)(t + 2) * kstep; const char* b2 = last ? nB : cB + (size_t)(t + 2) * kstep;
            const char* a3 = a2 + kstep; const char* b3 = b2 + kstep;
            PG8_LDB(B0, 0, 0); PG8_LDB(B1, 0, 1); PG8_SCHED; PG8_LDA(At, 0, 0); PG8_STAGE(PG8_SA(1, 1), a1 + hstepA, voffA);
            PG8_WAIT_V(8); PG8_WAIT_L(0); PG8_BAR; PG8_MMA(0, 0, At, B0); PG8_MMA(0, 1, At, B1); PG8_BAR; PG8_SCHED;
            PG8_LDA(At, 0, 1); PG8_STAGE(PG8_SB(0, 0), b2, voffB); PG8_STAGE(PG8_SB(0, 1), b2 + hstepB, voffB); PG8_STAGE(PG8_SA(0, 0), a2, voffA);
            PG8_WAIT_V(8); PG8_WAIT_L(0); PG8_BAR; PG8_MMA(1, 0, At, B0); PG8_MMA(1, 1, At, B1); PG8_BAR; PG8_SCHED;
            PG8_LDB(B0, 1, 0); PG8_LDB(B1, 1, 1); PG8_SCHED; PG8_LDA(At, 1, 0); PG8_STAGE(PG8_SA(0, 1), a2 + hstepA, voffA);
            PG8_WAIT_V(8); PG8_WAIT_L(0); PG8_BAR; PG8_MMA(0, 0, At, B0); PG8_MMA(0, 1, At, B1); PG8_BAR; PG8_SCHED;
            PG8_LDA(At, 1, 1); PG8_STAGE(PG8_SB(1, 0), b3, voffB); PG8_STAGE(PG8_SB(1, 1), b3 + hstepB, voffB); PG8_STAGE(PG8_SA(1, 0), a3, voffA);
            PG8_WAIT_V(8); PG8_WAIT_L(0); PG8_BAR; PG8_MMA(1, 0, At, B0); PG8_MMA(1, 1, At, B1); PG8_BAR; PG8_SCHED;
        }
        if constexpr (ALIGN_EPI) { if (wr == 0) PG8_BAR; }
        { int l2 = threadIdx.x; asm volatile("" : "+v"(l2)); E(acc, cur, wr, wc, l2 & 15, (l2 >> 4) & 3); }
        if (!has_next) break;
#pragma unroll
        for (int a = 0; a < 2; ++a)
#pragma unroll
            for (int b = 0; b < 2; ++b)
#pragma unroll
                for (int m = 0; m < 4; ++m)
#pragma unroll
                    for (int n = 0; n < 2; ++n) acc[a][b][m][n] = (f32x4){0.f, 0.f, 0.f, 0.f};
        cur = nxt; cA = nA; cB = nB; ++ui;
        if constexpr (ALIGN_EPI) { if (wr == 1) PG8_BAR; }
    }
    PG8_WAIT_V(0);
    if constexpr (!ALIGN_EPI) { if (wr == 0) PG8_BAR; }
    PG8_BAR;
#undef PG8_SA
#undef PG8_SB
#undef PG8_STAGE
#undef PG8_LDA
#undef PG8_LDB
#undef PG8_MMA
#undef PG8_WAIT_V
#undef PG8_WAIT_L
#undef PG8_BAR
#undef PG8_SCHED
}

typedef f32x4 Acc[2][2][4][2];
__device__ __forceinline__ float sigmoidf(float x) { return 1.f / (1.f + __expf(-x)); }
__device__ __forceinline__ float gelu_tanh(float x) { const float z = 0.7978845608028654f * (x + 0.044715f * x * x * x); return x * sigmoidf(2.f * z); }
__device__ __forceinline__ u32x4 pack8(const f32x4 a, const f32x4 b) { u32x4 w; w.x = pk2(a[0], a[1]); w.y = pk2(a[2], a[3]); w.z = pk2(b[0], b[1]); w.w = pk2(b[2], b[3]); return w; }

template <class T> __device__ __forceinline__ T* gp(const void* base, unsigned byteoff) { return (T*)((char*)base + byteoff); }
struct EpiSwiGLU {
    bf16_t* H;
    __device__ __forceinline__ void operator()(const Acc& acc, const Unit& u, int wr, int wc, int fr, int fq) const {
        const int row0 = u.pm * BM + wr * 64 + fr, hid = u.pn * 128 + wc * 32 + 8 * fq;
        const unsigned off0 = (unsigned)(row0 * FF + hid) * 2u;
#pragma unroll
        for (int ai = 0; ai < 2; ++ai)
#pragma unroll
            for (int m = 0; m < 4; ++m) {
                f32x4 o[2];
#pragma unroll
                for (int n = 0; n < 2; ++n)
#pragma unroll
                    for (int j = 0; j < 4; ++j) { const float gt = acc[ai][0][m][n][j], up = acc[ai][1][m][n][j]; o[n][j] = gt * sigmoidf(gt) * up; }
                *gp<u32x4>(H, off0 + (unsigned)((ai * HALF + m * 16) * FF) * 2u) = pack8(o[0], o[1]);
            }
    }
};
struct EpiResid {
    const float* x0; const float* x1; float* out; float s;
    __device__ __forceinline__ void operator()(const Acc& acc, const Unit& u, int wr, int wc, int fr, int fq) const {
        const int row0 = u.pm * BM + wr * 64 + fr, col0 = u.pn * BM + wc * 32 + 8 * fq;
        const bool lo = u.pm * BM < MP;
        const float* xb = lo ? x0 : x1;
        const unsigned xoff0 = (unsigned)((lo ? row0 : row0 - MP) * DM + col0) * 4u, ooff0 = (unsigned)(row0 * DM + col0) * 4u;
#pragma unroll
        for (int ai = 0; ai < 2; ++ai)
#pragma unroll
            for (int m = 0; m < 4; ++m) {
                const unsigned d = (unsigned)((ai * HALF + m * 16) * DM) * 4u;
#pragma unroll
                for (int bj = 0; bj < 2; ++bj) {
                    const f32x4 a = *gp<const f32x4>(xb, xoff0 + d + bj * HALF * 4), b = *gp<const f32x4>(xb, xoff0 + d + bj * HALF * 4 + 16);
                    *gp<f32x4>(out, ooff0 + d + bj * HALF * 4) = a * ALPHA + acc[ai][bj][m][0] * s;
                    *gp<f32x4>(out, ooff0 + d + bj * HALF * 4 + 16) = b * ALPHA + acc[ai][bj][m][1] * s;
                }
            }
    }
};
struct EpiWin {
    bf16_t* UEXT; bf16_t* PHY;
    __device__ __forceinline__ void operator()(const Acc& acc, const Unit& u, int wr, int wc, int fr, int fq) const {
        const int row0 = u.pm * BM + wr * 64 + fr, col0 = u.pn * BM + wc * 32 + 8 * fq;
        if (u.pn < 2) {
#pragma unroll
            for (int ai = 0; ai < 2; ++ai)
#pragma unroll
                for (int m = 0; m < 4; ++m) {
                    const int row = row0 + ai * HALF + m * 16, chunk = row >> 4, tl = row & 15;
#pragma unroll
                    for (int bj = 0; bj < 2; ++bj) { const int c0 = col0 + bj * HALF, g = c0 >> 4, h0 = c0 & 15;
                        *gp<u32x4>(UEXT, (unsigned)((g * NCHUNK + chunk) * 512 + tl * 16 + h0) * 2u) = pack8(acc[ai][bj][m][0], acc[ai][bj][m][1]); }
                }
        } else {
            const unsigned off0 = (unsigned)((col0 - 512) * MT + row0) * 2u;
#pragma unroll
            for (int bj = 0; bj < 2; ++bj)
#pragma unroll
                for (int n = 0; n < 2; ++n)
#pragma unroll
                    for (int j = 0; j < 4; ++j) {
                        const unsigned co = off0 + (unsigned)((bj * HALF + 4 * n + j) * MT) * 2u;
#pragma unroll
                        for (int ai = 0; ai < 2; ++ai)
#pragma unroll
                            for (int m = 0; m < 4; ++m) *gp<bf16_t>(PHY, co + (unsigned)(ai * HALF + m * 16) * 2u) = (bf16_t)f2bf(acc[ai][bj][m][n][j]);
                    }
        }
    }
};
struct EpiS {
    float* S;
    __device__ __forceinline__ void operator()(const Acc& acc, const Unit& u, int wr, int wc, int fr, int fq) const {
        const int row0 = u.pm * BM + wr * 64 + fr, col0 = wc * 32 + 8 * fq;
        const unsigned off0 = (unsigned)(row0 * 256 + col0) * 4u;
#pragma unroll
        for (int ai = 0; ai < 2; ++ai)
#pragma unroll
            for (int m = 0; m < 4; ++m) { const unsigned d = off0 + (unsigned)((ai * HALF + m * 16) * 256) * 4u;
#pragma unroll
                for (int bj = 0; bj < 2; ++bj) { *gp<f32x4>(S, d + bj * HALF * 4) = acc[ai][bj][m][0]; *gp<f32x4>(S, d + bj * HALF * 4 + 16) = acc[ai][bj][m][1]; } }
    }
};
struct EpiY {
    bf16_t* G;
    __device__ __forceinline__ void operator()(const Acc& acc, const Unit& u, int wr, int wc, int fr, int fq) const {
        const int g = u.pn, row0 = u.pm * BM + wr * 64 + fr - g * NCHUNK, col0 = wc * 32 + 8 * fq;
#pragma unroll
        for (int ai = 0; ai < 2; ++ai)
#pragma unroll
            for (int m = 0; m < 4; ++m) { const int chunk = row0 + ai * HALF + m * 16;
#pragma unroll
                for (int bj = 0; bj < 2; ++bj) { const int col = col0 + bj * HALF, t = col >> 4, h0 = col & 15;
                    f32x4 o[2];
#pragma unroll
                    for (int n = 0; n < 2; ++n)
#pragma unroll
                        for (int j = 0; j < 4; ++j) o[n][j] = gelu_tanh(acc[ai][bj][m][n][j]);
                    *gp<u32x4>(G, (unsigned)((chunk * 16 + t) * 512 + g * 16 + h0) * 2u) = pack8(o[0], o[1]); } }
    }
};
struct EpiGLU {
    const bf16_t* G; const float* bias; bf16_t* Y;
    __device__ __forceinline__ void operator()(const Acc& acc, const Unit& u, int wr, int wc, int fr, int fq) const {
        const int row0 = u.pm * BM + wr * 64 + fr, col0 = u.pn * BM + wc * 32 + 8 * fq;
#pragma unroll
        for (int bj = 0; bj < 2; ++bj) { const int col = col0 + bj * HALF;
            const f32x4 b0 = *(const f32x4*)(bias + col), b1 = *(const f32x4*)(bias + col + 4);
#pragma unroll
            for (int ai = 0; ai < 2; ++ai)
#pragma unroll
                for (int m = 0; m < 4; ++m) { const unsigned off = (unsigned)((row0 + ai * HALF + m * 16) * 512 + col) * 2u;
                    const u32x4 gv = *gp<const u32x4>(G, off);
                    const float gg[8] = {bf_lo(gv.x), bf_hi(gv.x), bf_lo(gv.y), bf_hi(gv.y), bf_lo(gv.z), bf_hi(gv.z), bf_lo(gv.w), bf_hi(gv.w)};
                    f32x4 o[2];
#pragma unroll
                    for (int j = 0; j < 4; ++j) { o[0][j] = gg[j] * sigmoidf(acc[ai][bj][m][0][j] + b0[j]); o[1][j] = gg[4 + j] * sigmoidf(acc[ai][bj][m][1][j] + b1[j]); }
                    *gp<u32x4>(Y, off) = pack8(o[0], o[1]); } }
    }
};
}

struct Params { const float* in[38]; float* out; unsigned char* ws; };
enum { I_XP = 0, I_XS, I_G1, I_U1, I_D1, I_LN1G, I_LN1B, I_WIN, I_LRE, I_LIM, I_LSTEP, I_BRE, I_BIM, I_CRE, I_CIM, I_SD, I_GLUW, I_GLUB, I_SNG,
       I_HSW, I_HSB, I_FW1, I_FB1, I_FW2, I_FB2, I_FW3, I_SFREQ, I_LDEC, I_HBIAS, I_HNG, I_WOUT, I_LN2G, I_LN2B, I_G2, I_U2, I_D2, I_LN3G, I_LN3B };

__device__ __forceinline__ void transpose_item(const float* W, int K, int N, bf16_t* WT, int k0, int n0, int dst_row0, LAS float* scr, int lane) {
#pragma unroll 8
    for (int i = 0; i < 32; ++i) { const int kk = 2 * i + (lane >> 5); scr[kk * 33 + (lane & 31)] = W[(size_t)(k0 + kk) * N + n0 + (lane & 31)]; }
    LDS_WAIT();
    const int c = lane & 7;
#pragma unroll
    for (int j = 0; j < 4; ++j) { const int n = (lane >> 3) + 8 * j; const LAS float* s = scr + (8 * c) * 33 + n;
        u32x4 o; o.x = pk2(s[0 * 33], s[1 * 33]); o.y = pk2(s[2 * 33], s[3 * 33]); o.z = pk2(s[4 * 33], s[5 * 33]); o.w = pk2(s[6 * 33], s[7 * 33]);
        *(u32x4*)(WT + (size_t)(dst_row0 + n) * K + k0 + 8 * c) = o; }
    LDS_WAIT();
}

__device__ __forceinline__ void transpose_job(const Params& P, int it, LAS float* scr, int lane) {
    unsigned char* ws = P.ws;
    const float* W; bf16_t* WT; int K, N, mode = 0;
    constexpr int I_GU = 16 * 88, I_D = 44 * 32, I_IN = 16 * 64, I_GL = 8 * 16, I_O = 16 * 32;
    int r = it;
    if (r < I_GU) { W = P.in[I_G1]; WT = (bf16_t*)(ws + WS_WGU1); K = DM; N = FF; mode = 1; }
    else if ((r -= I_GU) < I_GU) { W = P.in[I_U1]; WT = (bf16_t*)(ws + WS_WGU1); K = DM; N = FF; mode = 2; }
    else if ((r -= I_GU) < I_D) { W = P.in[I_D1]; WT = (bf16_t*)(ws + WS_WD1); K = FF; N = DM; }
    else if ((r -= I_D) < I_IN) { W = P.in[I_WIN]; WT = (bf16_t*)(ws + WS_WIN); K = DM; N = DIN; }
    else if ((r -= I_IN) < I_GL) { W = P.in[I_GLUW]; WT = (bf16_t*)(ws + WS_WGLU); K = 512; N = 512; }
    else if ((r -= I_GL) < I_O) { W = P.in[I_WOUT]; WT = (bf16_t*)(ws + WS_WOUT); K = DM; N = DM; }
    else if ((r -= I_O) < I_GU) { W = P.in[I_G2]; WT = (bf16_t*)(ws + WS_WGU2); K = DM; N = FF; mode = 1; }
    else if ((r -= I_GU) < I_GU) { W = P.in[I_U2]; WT = (bf16_t*)(ws + WS_WGU2); K = DM; N = FF; mode = 2; }
    else { r -= I_GU; W = P.in[I_D2]; WT = (bf16_t*)(ws + WS_WD2); K = FF; N = DM; }
    const int nblk = N / 32, kb = r / nblk, nb = r % nblk, k0 = 64 * kb, n0 = 32 * nb;
    const int dst = mode ? (256 * (n0 >> 7) + (n0 & 127) + (mode == 2 ? 128 : 0)) : n0;
    transpose_item(W, K, N, WT, k0, n0, dst, scr, lane);
}
constexpr int N_TRANSPOSE_ITEMS = 6 * 1408 + 1024 + 128 + 512;

__device__ __forceinline__ void filt_raw_item(LAS float* sm, const Params& P, int item, int tid) {
    LAS float* feats = sm;
    LAS float* h1 = sm + 640;
    LAS float* h2 = sm + 640 + 2048;
    const int t0 = item * 32;
    for (int fi = tid; fi < 32 * 17; fi += NTHREADS) { const int tt = fi / 17, f = fi % 17; const int t = t0 + tt; float v;
        if (f == 0) v = (float)t * (1.0f / 4096.0f);
        else { const int k = (f - 1) & 7; const float om = ((k & 1) ? 0.31622776601683794f : 1.0f) * ((k >> 1) == 0 ? 1.0f : (k >> 1) == 1 ? 0.1f : (k >> 1) == 2 ? 0.01f : 0.001f);
            const float p = (float)t * om, e = fmaf((float)t, om, -p); const float kk = rintf(p * 0.15915494309189535f);
            float r = fmaf(-kk, 6.28125f, p); r = fmaf(-kk, 1.9353071795864769e-3f, r) + e; v = (f <= 8) ? sinf(r) : cosf(r); }
        feats[tt * 20 + f] = v; }
    __syncthreads();
    const float* w1 = P.in[I_FW1]; const float* b1 = P.in[I_FB1]; const float* w2 = P.in[I_FW2]; const float* b2 = P.in[I_FB2]; const float* sf = P.in[I_SFREQ];
    for (int idx = tid; idx < 2048; idx += NTHREADS) { const int tt = idx >> 6, k = idx & 63; float s = b1[k];
#pragma unroll
        for (int f = 0; f < 17; ++f) s += feats[tt * 20 + f] * w1[f * 64 + k];
        h1[idx] = sinf(sf[k] * s); }
    __syncthreads();
    for (int idx = tid; idx < 2048; idx += NTHREADS) { const int tt = idx >> 6, k = idx & 63; float s = b2[k];
        for (int f = 0; f < 64; ++f) s += h1[tt * 64 + f] * w2[f * 64 + k];
        h2[idx] = sinf(sf[64 + k] * s); }
    __syncthreads();
    const int n = tid * 4; const float* w3 = P.in[I_FW3];
    const f32x4 ld = *(const f32x4*)(P.in[I_LDEC] + n);
    f32x4 rate; rate[0] = expf(ld[0]); rate[1] = expf(ld[1]); rate[2] = expf(ld[2]); rate[3] = expf(ld[3]);
    const bool bwd = ((n >> 9) & 1) != 0;
    float* FRAW = (float*)(P.ws + WS_FRAW);
    f32x4 asum = (f32x4){0.f, 0.f, 0.f, 0.f};
#pragma unroll 1
    for (int hf = 0; hf < 2; ++hf) {
        f32x4 acc[16];
#pragma unroll
        for (int tt = 0; tt < 16; ++tt) acc[tt] = (f32x4){0.f, 0.f, 0.f, 0.f};
#pragma unroll 1
        for (int k = 0; k < 64; k += 4) {
            const f32x4 wa = *(const f32x4*)(w3 + (size_t)(k + 0) * 2048 + n), wb = *(const f32x4*)(w3 + (size_t)(k + 1) * 2048 + n),
                        wc = *(const f32x4*)(w3 + (size_t)(k + 2) * 2048 + n), wd = *(const f32x4*)(w3 + (size_t)(k + 3) * 2048 + n);
#pragma unroll
            for (int tt = 0; tt < 16; ++tt) { const f32x4 hv = *(const LAS f32x4*)(h2 + (hf * 16 + tt) * 64 + k); acc[tt] += wa * hv[0] + wb * hv[1] + wc * hv[2] + wd * hv[3]; }
        }
#pragma unroll
        for (int tt = 0; tt < 16; ++tt) { const int t = t0 + hf * 16 + tt; const float tl = (float)t * (1.0f / 4096.0f);
            f32x4 v; v[0] = acc[tt][0] * expf(-tl * rate[0]); v[1] = acc[tt][1] * expf(-tl * rate[1]); v[2] = acc[tt][2] * expf(-tl * rate[2]); v[3] = acc[tt][3] * expf(-tl * rate[3]);
            *(f32x4*)(FRAW + (size_t)t * 2048 + n) = v;
            if (!(bwd && t == 0)) { asum[0] += fabsf(v[0]); asum[1] += fabsf(v[1]); asum[2] += fabsf(v[2]); asum[3] += fabsf(v[3]); } }
    }
    *(f32x4*)((float*)(P.ws + WS_PART) + (size_t)item * 2048 + n) = asum;
    __syncthreads();
}

__device__ __forceinline__ void s5_mats(LAS float* sm, const Params& P, int g, int tid) {
    LAS float* POWr = sm;
    LAS float* POWi = sm + 2176;
    LAS float* BBr = sm + 4352;
    LAS float* BBi = BBr + 2048;
    LAS float* Cr = BBi + 2048;
    LAS float* Ci = Cr + 2048;
    LAS float* Kt = Ci + 2048;
    const float* lre = P.in[I_LRE]; const float* lim = P.in[I_LIM]; const float* lst = P.in[I_LSTEP];
    for (int idx = tid; idx < 2176; idx += NTHREADS) { const int dir = idx / 1088, rem = idx % 1088, n = rem >> 6, p = rem & 63;
        const float step = expf(lst[dir * 32 + g]); const float lr = lre[(dir * 32 + g) * 64 + p], li = lim[(dir * 32 + g) * 64 + p];
        const float mag = expf(lr * step * (float)n), ang = li * step * (float)n;
        POWr[idx] = mag * cosf(ang); POWi[idx] = mag * sinf(ang); }
    for (int idx = tid; idx < 2048; idx += NTHREADS) { const int dir = idx >> 10, h = (idx >> 6) & 15, p = idx & 63;
        Cr[idx] = P.in[I_CRE][((size_t)(dir * 32 + g) * 16 + h) * 64 + p]; Ci[idx] = P.in[I_CIM][((size_t)(dir * 32 + g) * 16 + h) * 64 + p]; }
    __syncthreads();
    for (int idx = tid; idx < 2048; idx += NTHREADS) { const int dir = idx >> 10, p = (idx >> 4) & 63, h = idx & 15;
        const float lr = lre[(dir * 32 + g) * 64 + p], li = lim[(dir * 32 + g) * 64 + p];
        const float ar = POWr[dir * 1088 + 64 + p], ai = POWi[dir * 1088 + 64 + p];
        const float nr = ar - 1.0f, ni = ai, den = lr * lr + li * li;
        const float qr = (nr * lr + ni * li) / den, qi = (ni * lr - nr * li) / den;
        const float br = P.in[I_BRE][((size_t)(dir * 32 + g) * 64 + p) * 16 + h], bi = P.in[I_BIM][((size_t)(dir * 32 + g) * 64 + p) * 16 + h];
        BBr[idx] = qr * br - qi * bi; BBi[idx] = qr * bi + qi * br; }
    __syncthreads();
    for (int idx = tid; idx < 8192; idx += NTHREADS) { const int dir = idx >> 12, n = (idx >> 8) & 15, h = (idx >> 4) & 15, h2 = idx & 15; float s = 0.f;
        for (int p = 0; p < 64; ++p) { const float cr = Cr[dir * 1024 + h * 64 + p], ci = Ci[dir * 1024 + h * 64 + p], pr = POWr[dir * 1088 + n * 64 + p], pi = POWi[dir * 1088 + n * 64 + p];
            const float tr = cr * pr - ci * pi, ti = cr * pi + ci * pr; s += tr * BBr[dir * 1024 + p * 16 + h2] - ti * BBi[dir * 1024 + p * 16 + h2]; }
        Kt[idx] = s; }
    __syncthreads();
    bf16_t* WMAT = (bf16_t*)(P.ws + WS_WMAT) + (size_t)g * 256 * 512;
    bf16_t* WEND = (bf16_t*)(P.ws + WS_WEND) + (size_t)g * 256 * 256;
    const float* sd = P.in[I_SD] + g * 16;
    for (int idx = tid; idx < 256 * 256; idx += NTHREADS) {
        const int row = idx >> 8, col = (idx & 255) * 2, t = row >> 4, h = row & 15; float v[2];
#pragma unroll
        for (int e = 0; e < 2; ++e) { const int cc = col + e;
            if (cc < 256) { const int s = cc >> 4, h2 = cc & 15; float x = 0.f;
                if (s <= t) x += Kt[((0 * 16 + (t - s)) * 16 + h) * 16 + h2];
                if (s >= t) x += Kt[((1 * 16 + (s - t)) * 16 + h) * 16 + h2];
                if (s == t && h == h2) x += sd[h];
                v[e] = x; }
            else { const int c2 = cc - 256, dir = c2 >> 7, p = (c2 >> 1) & 63, ri = c2 & 1; const int ex = dir == 0 ? t + 1 : 16 - t;
                const float cr = Cr[dir * 1024 + h * 64 + p], ci = Ci[dir * 1024 + h * 64 + p], pr = POWr[dir * 1088 + ex * 64 + p], pi = POWi[dir * 1088 + ex * 64 + p];
                v[e] = ri == 0 ? (cr * pr - ci * pi) : -(cr * pi + ci * pr); } }
        *(unsigned*)(WMAT + (size_t)row * 512 + col) = pk2(v[0], v[1]); }
    for (int idx = tid; idx < 256 * 128; idx += NTHREADS) {
        const int row = idx >> 7, col = (idx & 127) * 2, dir = row >> 7, p = (row >> 1) & 63, ri = row & 1; float v[2];
#pragma unroll
        for (int e = 0; e < 2; ++e) { const int cc = col + e, s = cc >> 4, h2 = cc & 15; const int ex = dir == 0 ? 15 - s : s;
            const float pr = POWr[dir * 1088 + ex * 64 + p], pi = POWi[dir * 1088 + ex * 64 + p], br = BBr[dir * 1024 + p * 16 + h2], bi = BBi[dir * 1024 + p * 16 + h2];
            v[e] = ri == 0 ? (pr * br - pi * bi) : (pr * bi + pi * br); }
        *(unsigned*)(WEND + (size_t)row * 256 + col) = pk2(v[0], v[1]); }
    float* A16 = (float*)(P.ws + WS_SCAN);
    if (tid < 128) { const int dir = tid >> 6, p = tid & 63; A16[((g * 2 + dir) * 64 + p) * 2 + 0] = POWr[dir * 1088 + 16 * 64 + p]; A16[((g * 2 + dir) * 64 + p) * 2 + 1] = POWi[dir * 1088 + 16 * 64 + p]; }
    __syncthreads();
}

__device__ __forceinline__ void filt_norm_item(const Params& P, int it, LAS float* scr, int lane) {
    int ty, r = it;
    if (r < 1024) ty = 0; else { ty = 1; r -= 1024; }
    const int ntc = ty ? 4 : 16;
    const int tch = r % ntc; r /= ntc; const int ctile = r & 15; r >>= 4; const int dir = r & 1, o = r >> 1;
    const int L = ty ? LS : LP, RLEN = 2 * L + 64, C0 = L + 32, np = ty ? 64 : 256;
    const int cc = lane & 31, half = lane >> 5, c = ctile * 32 + cc, n = o * 1024 + dir * 512 + c;
    const float* PART = (const float*)(P.ws + WS_PART); const float* FRAW = (const float*)(P.ws + WS_FRAW);
    float s = 0.f;
    for (int i = 0; i < np; ++i) s += PART[(size_t)i * 2048 + o * 1024 + c] + PART[(size_t)i * 2048 + o * 1024 + 512 + c];
    const float inv = 1.0f / (s + FILTER_EPS);
    bf16_t* F = (bf16_t*)(P.ws + (ty ? WS_FS : WS_FP));
    for (int tt0 = tch * 512; tt0 < tch * 512 + 512; tt0 += 64) {
#pragma unroll 8
        for (int i = 0; i < 32; ++i) { const int tl = 2 * i + half; scr[tl * 33 + cc] = FRAW[(size_t)(tt0 + tl) * 2048 + n] * inv; }
        LDS_WAIT();
        const int t = tt0 + lane; const int idx = dir ? C0 + t : C0 - t; const bool wr = !(dir && t == 0);
        for (int c2 = 0; c2 < 32; ++c2) { const bf16_t v = (bf16_t)f2bf(scr[lane * 33 + c2]); bf16_t* dst = F + (size_t)(o * 512 + ctile * 32 + c2) * (2 * RLEN);
            if (wr) { dst[idx] = v; dst[RLEN + idx - 1] = v; } }
        LDS_WAIT();
    }
}
constexpr int N_FNORM_ITEMS = 1024 + 256;

__device__ __forceinline__ void ln_rows(float* X, bf16_t* XB, const float* gam, const float* bet, int gw, int ngw, int lane, bool wb) {
    f32x4 gv[4], bv[4];
#pragma unroll
    for (int j = 0; j < 4; ++j) { gv[j] = *(const f32x4*)(gam + 4 * lane + 256 * j); bv[j] = *(const f32x4*)(bet + 4 * lane + 256 * j); }
    for (int m = gw; m < MT; m += ngw) {
        float* xr = X + (size_t)m * DM + 4 * lane; f32x4 v[4]; float s = 0.f;
#pragma unroll
        for (int j = 0; j < 4; ++j) { v[j] = *(const f32x4*)(xr + 256 * j); s += (v[j][0] + v[j][1]) + (v[j][2] + v[j][3]); }
        const float mean = wave_sum(s) * (1.f / DM); float s2 = 0.f;
#pragma unroll
        for (int j = 0; j < 4; ++j) { v[j] = v[j] - mean; s2 += (v[j][0] * v[j][0] + v[j][1] * v[j][1]) + (v[j][2] * v[j][2] + v[j][3] * v[j][3]); }
        const float rstd = 1.f / sqrtf(wave_sum(s2) * (1.f / DM) + LN_EPS);
#pragma unroll
        for (int j = 0; j < 4; ++j) { const f32x4 o = v[j] * rstd * gv[j] + bv[j]; *(f32x4*)(xr + 256 * j) = o;
            if (wb) { u32x2 w; w.x = pk2(o[0], o[1]); w.y = pk2(o[2], o[3]); *(u32x2*)(XB + (size_t)m * DM + 4 * lane + 256 * j) = w; } }
    }
}

constexpr int ZERO_OFF = 131072;
#ifndef RING
#define RING 2
#endif
__device__ __forceinline__ bf16x8 ld_filt(const bf16_t* p) { const U4A4 v = *(const U4A4*)p; u32x4 w; w.x = v.x; w.y = v.y; w.z = v.z; w.w = v.w; return __builtin_bit_cast(bf16x8, w); }

template <int NB>
__device__ __forceinline__ void hyena_unit(LAS unsigned char* lds, const Params& P, int c, int ty) {
    constexpr int L = NB * 32, NT = NB / 32, RLEN = 2 * L + 64, C0 = L + 32, BPW = NB / 8;
    int tid_ = threadIdx.x; asm volatile("" : "+v"(tid_));
    const int tid = tid_, wave = __builtin_amdgcn_readfirstlane(tid >> 6), lane = tid & 63, n = lane & 31, hh = lane >> 5;
    const int tb = ty ? MP : 0;
    const bf16_t* PHY = (const bf16_t*)(P.ws + WS_H + 160 * MiB);
    bf16_t* YHY = (bf16_t*)(P.ws + WS_YHY);
    const bf16_t* FILT = (const bf16_t*)(P.ws + (ty ? WS_FS : WS_FP));
    const float* sw = P.in[I_HSW]; const float* sb = P.in[I_HSB];
    {
        const bf16_t* pv = PHY + (size_t)c * MT + tb;
        const float w0 = sw[c], w1 = sw[1536 + c], w2 = sw[3072 + c], bb = sb[c];
        if (tid == 0) *(LAS u32x4*)(lds + ZERO_OFF) = (u32x4){0u, 0u, 0u, 0u};
        for (int ci = tid; ci < L; ci += NTHREADS) {
            const int b = ci / (L / 8), t0 = (ci % (L / 8)) * 8;
            const bf16_t* p = pv + (size_t)b * L + t0;
            const u32x4 raw = *(const u32x4*)p;
            float x[10];
            x[0] = t0 > 0 ? bf2f(p[-1]) : 0.f; x[9] = (t0 + 8 < L) ? bf2f(p[8]) : 0.f;
            x[1] = bf_lo(raw.x); x[2] = bf_hi(raw.x); x[3] = bf_lo(raw.y); x[4] = bf_hi(raw.y); x[5] = bf_lo(raw.z); x[6] = bf_hi(raw.z); x[7] = bf_lo(raw.w); x[8] = bf_hi(raw.w);
            float v[8];
#pragma unroll
            for (int e = 0; e < 8; ++e) v[e] = bb + w0 * x[e] + w1 * x[e + 1] + w2 * x[e + 2];
            u32x4 o; o.x = pk2(v[0], v[1]); o.y = pk2(v[2], v[3]); o.z = pk2(v[4], v[5]); o.w = pk2(v[6], v[7]);
            const int row = (t0 >> 5) * 8 + b, chunk = (t0 & 31) >> 3;
            *(LAS u32x4*)(lds + row * 64 + ((chunk ^ ((row >> 2) & 3)) << 4)) = o;
        }
    }
    __syncthreads();
    const int i_lo = wave * BPW;
#pragma unroll 1
    for (int o = 0; o < 2; ++o) {
        const bf16_t* R0 = FILT + (size_t)(o * 512 + c) * (2 * RLEN);
        const int par = n & 1;
        const bf16_t* Rl = R0 + par * (RLEN - 1) + (C0 - n + 8 * hh);
        f32x16 acc[NT];
#pragma unroll
        for (int T = 0; T < NT; ++T)
#pragma unroll
            for (int e = 0; e < 16; ++e) acc[T][e] = 0.f;
        const int d0 = i_lo - (NB - 1); constexpr int nd = NB + BPW - 1;
        const int swE = (n >> 2) & 3, swO = ((n >> 2) + 2) & 3;
        const int offE0 = n * 64 + ((hh ^ swE) << 4), offE1 = n * 64 + (((2 + hh) ^ swE) << 4);
        const int offO0 = n * 64 + ((hh ^ swO) << 4), offO1 = n * 64 + (((2 + hh) ^ swO) << 4);
        bf16x8 A[RING][2];
#pragma unroll
        for (int u = 0; u < RING; ++u) { A[u][0] = ld_filt(Rl - 32 * (d0 + u)); A[u][1] = ld_filt(Rl - 32 * (d0 + u) + 16); }
#pragma unroll 1
        for (int dd = 0; dd < nd; dd += RING) {
#pragma unroll
            for (int u = 0; u < RING; ++u) {
                const int d = d0 + dd + u;
                if (dd + u < nd) {
                    const int jb = i_lo - d;
                    const int o0 = (jb & 1) ? offO0 : offE0, o1 = (jb & 1) ? offO1 : offE1;
                    const int base0 = jb * 512 + o0, base1 = jb * 512 + o1;
#pragma unroll
                    for (int T = 0; T < NT; ++T) {
                        const int j0 = jb + 4 * T;
                        if (j0 > -4 && j0 < NB) {
                            const int row = j0 * 8 + n; const bool valid = (unsigned)row < (unsigned)(NB * 8);
                            const int a0 = valid ? base0 + T * 2048 : ZERO_OFF, a1 = valid ? base1 + T * 2048 : ZERO_OFF;
                            const bf16x8 b0 = *(const LAS bf16x8*)(lds + a0), b1 = *(const LAS bf16x8*)(lds + a1);
                            acc[T] = __builtin_amdgcn_mfma_f32_32x32x16_bf16(A[u][0], b0, acc[T], 0, 0, 0);
                            acc[T] = __builtin_amdgcn_mfma_f32_32x32x16_bf16(A[u][1], b1, acc[T], 0, 0, 0);
                        }
                    }
                }
                if (dd + u + RING < nd) { A[u][0] = ld_filt(Rl - 32 * (d + RING)); A[u][1] = ld_filt(Rl - 32 * (d + RING) + 16); }
            }
        }
        __syncthreads();
        {
            const int gch = 512 * (o + 1) + c;
            const bf16_t* pg = PHY + (size_t)gch * MT + tb;
            const float w0 = sw[gch], w1 = sw[1536 + gch], w2 = sw[3072 + gch], bb = sb[gch];
            const float hb = P.in[I_HBIAS][o * 512 + c];
            const int b = n & 7;
#pragma unroll
            for (int T = 0; T < NT; ++T) {
                const int ib = i_lo + 4 * T + (n >> 3), row = ib * 8 + b;
#pragma unroll
                for (int rg = 0; rg < 4; ++rg) {
                    const int t = 32 * ib + 8 * rg + 4 * hh;
                    const bf16_t* p = pg + (size_t)b * L + t;
                    const u32x2 raw = *(const u32x2*)p;
                    const float xm = t > 0 ? bf2f(p[-1]) : 0.f, xp = (t + 4 < L) ? bf2f(p[4]) : 0.f;
                    const float x1 = bf_lo(raw.x), x2 = bf_hi(raw.x), x3 = bf_lo(raw.y), x4 = bf_hi(raw.y);
                    const float g0 = bb + w0 * xm + w1 * x1 + w2 * x2, g1 = bb + w0 * x1 + w1 * x2 + w2 * x3, g2 = bb + w0 * x2 + w1 * x3 + w2 * x4, g3 = bb + w0 * x3 + w1 * x4 + w2 * xp;
                    const int za = row * 64 + ((rg ^ ((row >> 2) & 3)) << 4) + 8 * hh;
                    const u32x2 zr = *(const LAS u32x2*)(lds + za);
                    const float z0 = g0 * (acc[T][4 * rg + 0] + hb * bf_lo(zr.x)), z1 = g1 * (acc[T][4 * rg + 1] + hb * bf_hi(zr.x)),
                                z2 = g2 * (acc[T][4 * rg + 2] + hb * bf_lo(zr.y)), z3 = g3 * (acc[T][4 * rg + 3] + hb * bf_hi(zr.y));
                    u32x2 w; w.x = pk2(z0, z1); w.y = pk2(z2, z3);
                    if (o == 0) *(LAS u32x2*)(lds + za) = w;
                    else *(u32x2*)(YHY + (size_t)c * MT + tb + (size_t)b * L + t) = w;
                }
                __builtin_amdgcn_sched_barrier(0);
            }
        }
        __syncthreads();
    }
}

#ifndef PHMASK
#define PHMASK 0xFFFFFF
#endif
#define PH(k) if constexpr ((PHMASK >> (k)) & 1)
#define FRESH() int tid_ = threadIdx.x; asm volatile("" : "+v"(tid_)); const int tid = tid_, lane = tid & 63, wave = __builtin_amdgcn_readfirstlane(tid >> 6); \
    const int gw = bx * NWAVES + wave; unsigned char* ws = P.ws; asm volatile("" : "+s"(ws)); (void)lane; (void)gw; (void)tid
__global__ void __launch_bounds__(NTHREADS, 2) mega_fwd(Params P) {
    extern __shared__ __attribute__((aligned(16))) unsigned char lds_raw[];
    LAS unsigned char* lds = (LAS unsigned char*)lds_raw;
    cg::grid_group grid = cg::this_grid();
    const int G = gridDim.x, bx = blockIdx.x, NGW = G * NWAVES;

    PH(16) { FRESH(); for (int it = bx; it < 256; it += G) filt_raw_item((LAS float*)lds, P, it, tid); }
    PH(17) { FRESH(); for (int g = bx; g < 32; g += G) s5_mats((LAS float*)lds, P, g, tid); }
    PH(0) { FRESH();
        LAS float* scr = (LAS float*)(lds + wave * 16384);
        for (int it = gw; it < N_TRANSPOSE_ITEMS; it += NGW) transpose_job(P, it, scr, lane);
        bf16_t* XB = (bf16_t*)(ws + WS_XB);
        for (int m = gw; m < MT; m += NGW) {
            const float* xr = (m < MP ? P.in[I_XP] + (size_t)m * DM : P.in[I_XS] + (size_t)(m - MP) * DM) + 4 * lane;
#pragma unroll
            for (int j = 0; j < 4; ++j) { const f32x4 v = *(const f32x4*)(xr + 256 * j); u32x2 w; w.x = pk2(v[0], v[1]); w.y = pk2(v[2], v[3]); *(u32x2*)(XB + (size_t)m * DM + 4 * lane + 256 * j) = w; }
        }
    }
    grid.sync();
    PH(1) { FRESH(); pg8::Gemm g{(bf16_t*)(ws + WS_XB), (const bf16_t*)(ws + WS_WGU1), DM, DM, DM}; pg8::StaticOrder So; So.init(MT, 2 * FF, G, bx); pg8::EpiSwiGLU E{(bf16_t*)(ws + WS_H)};
      pg8::gemm_phase<pg8::EpiSwiGLU, pg8::StaticOrder, true>(lds, g, So, E); }
    grid.sync();
    PH(2) { FRESH(); pg8::Gemm g{(bf16_t*)(ws + WS_H), (const bf16_t*)(ws + WS_WD1), FF, FF, FF}; pg8::StaticOrder So; So.init(MT, DM, G, bx); pg8::EpiResid E{P.in[I_XP], P.in[I_XS], P.out, 0.5f};
      pg8::gemm_phase<pg8::EpiResid, pg8::StaticOrder, true>(lds, g, So, E); }
    grid.sync();
    PH(3) { FRESH(); ln_rows(P.out, (bf16_t*)(ws + WS_XB), P.in[I_LN1G], P.in[I_LN1B], gw, NGW, lane, true); }
    PH(18) { FRESH(); LAS float* scr = (LAS float*)(lds + wave * 16384);
      for (int it = gw; it < N_FNORM_ITEMS; it += NGW) filt_norm_item(P, it, scr, lane); }
    grid.sync();
    PH(4) { FRESH(); pg8::Gemm g{(bf16_t*)(ws + WS_XB), (const bf16_t*)(ws + WS_WIN), DM, DM, DM}; pg8::StaticOrder So; So.init(MT, DIN, G, bx); pg8::EpiWin E{(bf16_t*)(ws + WS_H), (bf16_t*)(ws + WS_H + 160 * MiB)};
      pg8::gemm_phase<pg8::EpiWin, pg8::StaticOrder, true>(lds, g, So, E); }
    grid.sync();
    PH(5) { FRESH(); pg8::Gemm g{(bf16_t*)(ws + WS_H), (const bf16_t*)(ws + WS_WEND), 256, 512, 256}; pg8::GroupOrder So{G, bx}; pg8::EpiS E{(float*)(ws + WS_XB)};
      pg8::gemm_phase<pg8::EpiS, pg8::GroupOrder, true>(lds, g, So, E); }
    grid.sync();
    PH(6) { FRESH();
        const float* A16 = (const float*)(ws + WS_SCAN); const float* S = (const float*)(ws + WS_XB); bf16_t* UEXT = (bf16_t*)(ws + WS_H);
        for (int id = wave * G + bx; id < 1024; id += NGW) {
            const int ty = id >> 9, rest = id & 511, b = rest >> 6, g = (rest >> 1) & 31, dir = rest & 1;
            const int NC = ty ? 128 : 512, cbase = ty ? 4096 + b * 128 : b * 512;
            const float ar = A16[((g * 2 + dir) * 64 + lane) * 2], ai = A16[((g * 2 + dir) * 64 + lane) * 2 + 1];
            const f32x2* Sp = (const f32x2*)(S + (size_t)(g * NCHUNK + cbase) * 256 + dir * 128) + lane;
            unsigned* Hp = (unsigned*)(UEXT + (size_t)(g * NCHUNK + cbase) * 512 + 256 + dir * 128) + lane;
            float hr = 0.f, hi = 0.f;
            for (int c0 = 0; c0 < NC; c0 += 8) {
                f32x2 s[8];
#pragma unroll
                for (int k = 0; k < 8; ++k) { const int ci = dir ? NC - 1 - (c0 + k) : c0 + k; s[k] = Sp[(size_t)ci * 128]; }
#pragma unroll
                for (int k = 0; k < 8; ++k) { const int ci = dir ? NC - 1 - (c0 + k) : c0 + k; Hp[(size_t)ci * 256] = pk2(hr, hi);
                    const float nr = ar * hr - ai * hi + s[k][0], ni = ar * hi + ai * hr + s[k][1]; hr = nr; hi = ni; }
            }
        }
    }
    grid.sync();
    PH(7) { FRESH(); pg8::Gemm g{(bf16_t*)(ws + WS_H), (const bf16_t*)(ws + WS_WMAT), 512, 512, 512}; pg8::GroupOrder So{G, bx}; pg8::EpiY E{(bf16_t*)(ws + WS_XB)};
      pg8::gemm_phase<pg8::EpiY, pg8::GroupOrder, true>(lds, g, So, E); }
    grid.sync();
    PH(8) { FRESH(); pg8::Gemm g{(bf16_t*)(ws + WS_XB), (const bf16_t*)(ws + WS_WGLU), 512, 512, 512}; pg8::StaticOrder So; So.init(MT, 512, G, bx); pg8::EpiGLU E{(bf16_t*)(ws + WS_XB), P.in[I_GLUB], (bf16_t*)(ws + WS_XB + 80 * MiB)};
      pg8::gemm_phase<pg8::EpiGLU, pg8::StaticOrder, true>(lds, g, So, E); }
    PH(9) {
#pragma unroll 1
        for (int u = bx; u < 512; u += G) hyena_unit<256>(lds, P, u, 0);
#pragma unroll 1
        for (int u = bx; u < 512; u += G) hyena_unit<64>(lds, P, u, 1);
    }
    grid.sync();
    PH(10) { FRESH();
        const float* sng = P.in[I_SNG]; const float* hng = P.in[I_HNG];
        const bf16_t* YHY = (const bf16_t*)(ws + WS_YHY); const bf16_t* YSSM = (const bf16_t*)(ws + WS_XB + 80 * MiB); bf16_t* MIXED = (bf16_t*)(ws + WS_H);
        LAS unsigned* tile = (LAS unsigned*)lds;
        for (int tl = bx; tl < MT / 64; tl += G) {
            const int tok0 = tl * 64;
            for (int ci = tid; ci < 512 * 8; ci += NTHREADS) { const int c = ci >> 3, q = ci & 7; const u32x4 v = *(const u32x4*)(YHY + (size_t)c * MT + tok0 + q * 8);
                tile[c * 33 + q * 4 + 0] = v.x; tile[c * 33 + q * 4 + 1] = v.y; tile[c * 33 + q * 4 + 2] = v.z; tile[c * 33 + q * 4 + 3] = v.w; }
            for (int r = 0; r < 8; ++r) { const int tok = tok0 + wave * 8 + r;
                const u32x4 v = *(const u32x4*)(YSSM + (size_t)tok * 512 + 8 * lane);
                float x[8] = {bf_lo(v.x), bf_hi(v.x), bf_lo(v.y), bf_hi(v.y), bf_lo(v.z), bf_hi(v.z), bf_lo(v.w), bf_hi(v.w)}; float ss = 0.f;
#pragma unroll
                for (int e = 0; e < 8; ++e) ss += x[e] * x[e];
                const float sc = 1.f / sqrtf(wave_sum(ss) * (1.f / 512.f) + RMS_EPS);
                const f32x4 g0 = *(const f32x4*)(sng + 8 * lane), g1 = *(const f32x4*)(sng + 8 * lane + 4);
                u32x4 w; w.x = pk2(x[0] * sc * g0[0], x[1] * sc * g0[1]); w.y = pk2(x[2] * sc * g0[2], x[3] * sc * g0[3]); w.z = pk2(x[4] * sc * g1[0], x[5] * sc * g1[1]); w.w = pk2(x[6] * sc * g1[2], x[7] * sc * g1[3]);
                *(u32x4*)(MIXED + (size_t)tok * DM + 8 * lane) = w; }
            __syncthreads();
            for (int r = 0; r < 4; ++r) { const int tp = wave * 4 + r; float xa[8], xb[8], sa = 0.f, sb2 = 0.f;
#pragma unroll
                for (int k = 0; k < 8; ++k) { const unsigned v = tile[(lane + 64 * k) * 33 + tp]; xa[k] = bf_lo(v); xb[k] = bf_hi(v); sa += xa[k] * xa[k]; sb2 += xb[k] * xb[k]; }
                const float sca = 1.f / sqrtf(wave_sum(sa) * (1.f / 512.f) + RMS_EPS), scb = 1.f / sqrtf(wave_sum(sb2) * (1.f / 512.f) + RMS_EPS);
                bf16_t* oa = MIXED + (size_t)(tok0 + 2 * tp) * DM + 512; bf16_t* ob = oa + DM;
#pragma unroll
                for (int k = 0; k < 8; ++k) { const float gg = hng[lane + 64 * k]; oa[lane + 64 * k] = (bf16_t)f2bf(xa[k] * sca * gg); ob[lane + 64 * k] = (bf16_t)f2bf(xb[k] * scb * gg); } }
            __syncthreads();
        }
    }
    grid.sync();
    PH(11) { FRESH(); pg8::Gemm g{(bf16_t*)(ws + WS_H), (const bf16_t*)(ws + WS_WOUT), DM, DM, DM}; pg8::StaticOrder So; So.init(MT, DM, G, bx); pg8::EpiResid E{P.out, P.out + (size_t)MP * DM, P.out, 1.0f};
      pg8::gemm_phase<pg8::EpiResid, pg8::StaticOrder, true>(lds, g, So, E); }
    grid.sync();
    PH(12) { FRESH(); ln_rows(P.out, (bf16_t*)(ws + WS_XB), P.in[I_LN2G], P.in[I_LN2B], gw, NGW, lane, true); }
    grid.sync();
    PH(13) { FRESH(); pg8::Gemm g{(bf16_t*)(ws + WS_XB), (const bf16_t*)(ws + WS_WGU2), DM, DM, DM}; pg8::StaticOrder So; So.init(MT, 2 * FF, G, bx); pg8::EpiSwiGLU E{(bf16_t*)(ws + WS_H)};
      pg8::gemm_phase<pg8::EpiSwiGLU, pg8::StaticOrder, true>(lds, g, So, E); }
    grid.sync();
    PH(14) { FRESH(); pg8::Gemm g{(bf16_t*)(ws + WS_H), (const bf16_t*)(ws + WS_WD2), FF, FF, FF}; pg8::StaticOrder So; So.init(MT, DM, G, bx); pg8::EpiResid E{P.out, P.out + (size_t)MP * DM, P.out, 0.5f};
      pg8::gemm_phase<pg8::EpiResid, pg8::StaticOrder, true>(lds, g, So, E); }
    grid.sync();
    PH(15) { FRESH(); ln_rows(P.out, (bf16_t*)(ws + WS_XB), P.in[I_LN3G], P.in[I_LN3B], gw, NGW, lane, false); }
}

extern "C" void kernel_launch(void* const* d_in, const int* in_sizes, int n_in, void* d_out, int out_size, void* d_ws, size_t ws_size, hipStream_t stream) {
    static int grid = 0;
    if (grid == 0) {
        if (n_in != 38 || out_size != MT * DM || ws_size < WS_END) { fprintf(stderr, "kernel_launch: unexpected problem: n_in %d out %d ws %zu (need %zu)\n", n_in, out_size, ws_size, (size_t)WS_END); grid = -1; return; }
        int dev = 0, cus = 0, per_cu = 0;
        hipGetDevice(&dev);
        hipDeviceGetAttribute(&cus, hipDeviceAttributeMultiprocessorCount, dev);
        hipFuncSetAttribute((const void*)mega_fwd, hipFuncAttributeMaxDynamicSharedMemorySize, LDS_BYTES);
        hipOccupancyMaxActiveBlocksPerMultiprocessor(&per_cu, (const void*)mega_fwd, NTHREADS, LDS_BYTES);
        if (per_cu < 1) { fprintf(stderr, "kernel_launch: occupancy query says %d blocks per CU\n", per_cu); per_cu = 1; }
        (void)hipGetLastError();
        grid = cus * per_cu;
        fprintf(stderr, "kernel_launch: grid %d (cus %d x %d)\n", grid, cus, per_cu);
    }
    if (grid < 0) return;
    Params p{};
    for (int i = 0; i < 38; ++i) p.in[i] = (const float*)d_in[i];
    p.out = (float*)d_out; p.ws = (unsigned char*)d_ws;
    void* args[] = {&p};
    hipError_t e = hipLaunchCooperativeKernel((const void*)mega_fwd, dim3(grid), dim3(NTHREADS), args, LDS_BYTES, stream);
    if (e != hipSuccess) fprintf(stderr, "cooperative launch failed: %s (grid %d)\n", hipGetErrorString(e), grid);
}
```

```cpp
#include <hip/hip_runtime.h>
#include <hip/hip_cooperative_groups.h>
#include <cstdio>
#include <cstdint>
namespace cg = cooperative_groups;

#define LAS __attribute__((address_space(3)))
typedef unsigned short bf16_t;
typedef short bf16x8 __attribute__((ext_vector_type(8)));
typedef float f32x4 __attribute__((ext_vector_type(4)));
typedef float f32x2 __attribute__((ext_vector_type(2)));
typedef float f32x16 __attribute__((ext_vector_type(16)));
typedef unsigned u32x4 __attribute__((ext_vector_type(4)));
typedef unsigned u32x2 __attribute__((ext_vector_type(2)));
struct __attribute__((packed, aligned(4))) U4A4 { unsigned x, y, z, w; };

constexpr int MP = 65536, MS = 16384, MT = 81920, DM = 1024, FF = 2816, DIN = 2048;
constexpr int LP = 8192, LS = 2048;
constexpr int NCHUNK = MT / 16;
constexpr float ALPHA = 1.189207115002721f;
constexpr float LN_EPS = 1e-5f, RMS_EPS = 1e-6f, FILTER_EPS = 1e-6f;
constexpr int NTHREADS = 512, NWAVES = 8;
constexpr int LDS_BYTES = 147456;

constexpr size_t MiB = 1u << 20;
constexpr size_t WS_WGU1 = 0 * MiB, WS_WD1 = 12 * MiB, WS_WIN = 18 * MiB, WS_WGLU = 22 * MiB, WS_WOUT = 23 * MiB, WS_WGU2 = 25 * MiB, WS_WD2 = 36 * MiB;
constexpr size_t WS_WEND = 42 * MiB, WS_WMAT = 46 * MiB, WS_SCAN = 54 * MiB, WS_PART = 55 * MiB  ;
constexpr size_t WS_XB = 58 * MiB;
constexpr size_t WS_H = 218 * MiB;
constexpr size_t WS_YHY = 658 * MiB;
constexpr size_t WS_FRAW = 738 * MiB;
constexpr size_t WS_FP = 802 * MiB;
constexpr size_t WS_FS = 868 * MiB;
constexpr size_t WS_END = 886 * MiB;

__device__ __forceinline__ unsigned f2bf(float f) { unsigned u = __builtin_bit_cast(unsigned, f); return (u + 0x7fffu + ((u >> 16) & 1u)) >> 16; }
__device__ __forceinline__ unsigned pk2(float lo, float hi) { unsigned r; asm("v_cvt_pk_bf16_f32 %0, %1, %2" : "=v"(r) : "v"(lo), "v"(hi)); return r; }
__device__ __forceinline__ float bf_lo(unsigned u) { return __builtin_bit_cast(float, u << 16); }
__device__ __forceinline__ float bf_hi(unsigned u) { return __builtin_bit_cast(float, u & 0xffff0000u); }
__device__ __forceinline__ float bf2f(bf16_t h) { return __builtin_bit_cast(float, (unsigned)h << 16); }
__device__ __forceinline__ float wave_sum(float v) {
#pragma unroll
    for (int o = 1; o < 64; o <<= 1) v += __shfl_xor(v, o);
    return v;
}
#define LDS_WAIT() asm volatile("s_waitcnt lgkmcnt(0)" ::: "memory")

namespace pg8 {
constexpr int BM = 256, BK = 64, HALF = 128, HTB = HALF * BK * 2, NXCD = 8, WGM = 8;
__device__ __forceinline__ int lds_byte(int r, int c) { const int st = (r >> 4) * 2 + (c >> 5), rr = r & 15, cc = c & 31, ob = rr * 64 + cc * 2; return st * 1024 + (ob ^ (((ob >> 9) & 1) << 5)); }
__device__ __forceinline__ void stage_rc(int b, int& R, int& C) { const int st = b / 1024, sb = b % 1024, swz = sb ^ (((sb >> 9) & 1) << 5); R = (st >> 1) * 16 + swz / 64; C = (st & 1) * 32 + (swz % 64) / 2; }
__device__ __forceinline__ int perm32(int rho) { const int n = rho >> 4, i = rho & 15; return 8 * (i >> 2) + 4 * n + (i & 3); }
struct Unit { int pm, pn; };
struct Gemm { const bf16_t* A; const bf16_t* Bt; int K, lda, ldb; };
struct StaticOrder {
    int nM, nN, nwg, G, c;
    __device__ void init(int M, int N, int G_, int c_) { nM = M / BM; nN = N / BM; nwg = nM * nN; G = G_; c = c_; }
    __device__ bool next(int i, Unit& u) const {
        const long L = (long)i * G + c; if (L >= nwg) return false;
        int wgid = (int)L; { const int q = nwg / NXCD, r = nwg % NXCD, xcd = wgid % NXCD, off = wgid / NXCD; wgid = (xcd < r ? xcd * (q + 1) : r * (q + 1) + (xcd - r) * q) + off; }
        const int nig = WGM * nN, gid = wgid / nig, fm = gid * WGM, gsz = (nM - fm) < WGM ? (nM - fm) : WGM;
        u.pm = fm + ((wgid % nig) % gsz); u.pn = (wgid % nig) / gsz; return true;
    }
};
struct GroupOrder {
    int G, c;
    __device__ bool next(int i, Unit& u) const { const int L = i * G + c; if (L >= 640) return false; u.pm = L; u.pn = L / 20; return true; }
};

template <class Epi, class Sched, bool ALIGN_EPI>
__device__ __forceinline__ void gemm_phase(LAS unsigned char* lds, const Gemm g, const Sched& S, const Epi& E) {
    int tid_ = threadIdx.x; asm volatile("" : "+v"(tid_));
    const int tid = tid_, wid = __builtin_amdgcn_readfirstlane(tid >> 6), lane = tid & 63, wr = wid >> 2, wc = wid & 3, fr = lane & 15, fq = lane >> 4;
    const int K = g.K, nt = K / BK;
    unsigned voffA[2], voffB[2];
#pragma unroll
    for (int i = 0; i < 2; ++i) { int R, C; stage_rc(tid * 16 + i * 8192, R, C); const int Rb = (R & ~31) + perm32(R & 31);
        voffA[i] = (unsigned)(R * g.lda + C) * 2u; voffB[i] = (unsigned)(Rb * g.ldb + C) * 2u; }
    const size_t kstep = (size_t)(BK * 2);
    const size_t hstepA = (size_t)HALF * g.lda * 2, hstepB = (size_t)HALF * g.ldb * 2;
    const size_t tstepA = 2 * hstepA, tstepB = 2 * hstepB;
    const unsigned ldsw = (unsigned)wid * 1024u;
    const int aoff = lds_byte(wr * 64 + fr, fq * 8), boff = lds_byte(wc * 32 + fr, fq * 8);
#define PG8_SA(b, h) (((b) * 2 + (h)) * HTB)
#define PG8_SB(b, h) ((4 + (b) * 2 + (h)) * HTB)
#define PG8_STAGE(bufoff, gbase, voff) do { _Pragma("unroll") for (int _i = 0; _i < 2; ++_i) \
        __builtin_amdgcn_global_load_lds((const unsigned*)((const char*)(gbase) + (voff)[_i]), (LAS unsigned*)(lds + (bufoff) + ldsw + _i * 8192), 16, 0, 0); } while (0)
#define PG8_LDA(dst, b, h) do { _Pragma("unroll") for (int m = 0; m < 4; ++m) _Pragma("unroll") for (int k = 0; k < 2; ++k) dst[m][k] = *(const LAS bf16x8*)(lds + PG8_SA(b, h) + aoff + m * 2048 + k * 1024); } while (0)
#define PG8_LDB(dst, b, h) do { _Pragma("unroll") for (int n = 0; n < 2; ++n) _Pragma("unroll") for (int k = 0; k < 2; ++k) dst[n][k] = *(const LAS bf16x8*)(lds + PG8_SB(b, h) + boff + n * 2048 + k * 1024); } while (0)
#define PG8_MMA(ai, bj, At, Bt) do { __builtin_amdgcn_s_setprio(1); _Pragma("unroll") for (int m = 0; m < 4; ++m) _Pragma("unroll") for (int n = 0; n < 2; ++n) _Pragma("unroll") for (int k = 0; k < 2; ++k) \
        acc[ai][bj][m][n] = __builtin_amdgcn_mfma_f32_16x16x32_bf16(Bt[n][k], At[m][k], acc[ai][bj][m][n], 0, 0, 0); __builtin_amdgcn_s_setprio(0); } while (0)
#define PG8_WAIT_V(n) asm volatile("s_waitcnt vmcnt(" #n ")" ::: "memory")
#define PG8_WAIT_L(n) asm volatile("s_waitcnt lgkmcnt(" #n ")" ::: "memory")
#define PG8_BAR __builtin_amdgcn_s_barrier()
#define PG8_SCHED __builtin_amdgcn_sched_barrier(0)
    Unit cur, nxt; int ui = 0;
    if (!S.next(0, cur)) return;
    f32x4 acc[2][2][4][2];
#pragma unroll
    for (int a = 0; a < 2; ++a)
#pragma unroll
        for (int b = 0; b < 2; ++b)
#pragma unroll
            for (int m = 0; m < 4; ++m)
#pragma unroll
                for (int n = 0; n < 2; ++n) acc[a][b][m][n] = (f32x4){0.f, 0.f, 0.f, 0.f};
    bf16x8 At[4][2], B0[2][2], B1[2][2];
    const char* cA = (const char*)g.A + (size_t)cur.pm * tstepA; const char* cB = (const char*)g.Bt + (size_t)cur.pn * tstepB;
    PG8_STAGE(PG8_SB(0, 0), cB, voffB); PG8_STAGE(PG8_SB(0, 1), cB + hstepB, voffB); PG8_STAGE(PG8_SA(0, 0), cA, voffA); PG8_STAGE(PG8_SA(0, 1), cA + hstepA, voffA);
    if (wr == 1) PG8_BAR;
    PG8_WAIT_V(2); PG8_BAR;
    PG8_STAGE(PG8_SB(1, 0), cB + kstep, voffB); PG8_STAGE(PG8_SA(1, 0), cA + kstep, voffA); PG8_STAGE(PG8_SB(1, 1), cB + hstepB + kstep, voffB);
    PG8_WAIT_V(6); PG8_BAR;
    for (;;) {
        const bool has_next = S.next(ui + 1, nxt);
        const char* nA = has_next ? (const char*)g.A + (size_t)nxt.pm * tstepA : cA; const char* nB = has_next ? (const char*)g.Bt + (size_t)nxt.pn * tstepB : cB;
        for (int t = 0; t < nt; t += 2) {
            const bool last = (t == nt - 2);
            const char* a1 = cA + (size_t)(t + 1) * kstep;
            const char* a2 = last ? nA : cA + (size_t)(t + 2) * kstep; const char* b2 = last ? nB : cB + (size_t)(t + 2) * kstep;
            const char* a3 = a2 + kstep; const char* b3 = b2 + kstep;
            PG8_LDB(B0, 0, 0); PG8_LDB(B1, 0, 1); PG8_SCHED; PG8_LDA(At, 0, 0); PG8_STAGE(PG8_SA(1, 1), a1 + hstepA, voffA);
            PG8_WAIT_V(8); PG8_WAIT_L(0); PG8_BAR; PG8_MMA(0, 0, At, B0); PG8_MMA(0, 1, At, B1); PG8_BAR; PG8_SCHED;
            PG8_LDA(At, 0, 1); PG8_STAGE(PG8_SB(0, 0), b2, voffB); PG8_STAGE(PG8_SB(0, 1), b2 + hstepB, voffB); PG8_STAGE(PG8_SA(0, 0), a2, voffA);
            PG8_WAIT_V(8); PG8_WAIT_L(0); PG8_BAR; PG8_MMA(1, 0, At, B0); PG8_MMA(1, 1, At, B1); PG8_BAR; PG8_SCHED;
            PG8_LDB(B0, 1, 0); PG8_LDB(B1, 1, 1); PG8_SCHED; PG8_LDA(At, 1, 0); PG8_STAGE(PG8_SA(0, 1), a2 + hstepA, voffA);
            PG8_WAIT_V(8); PG8_WAIT_L(0); PG8_BAR; PG8_MMA(0, 0, At, B0); PG8_MMA(0, 1, At, B1); PG8_BAR; PG8_SCHED;
            PG8_LDA(At, 1, 1); PG8_STAGE(PG8_SB(1, 0), b3, voffB); PG8_STAGE(PG8_SB(1, 1), b3 + hstepB, voffB); PG8_STAGE(PG8_SA(1, 0), a3, voffA);
            PG8_WAIT_V(8); PG8_WAIT_L(0); PG8_BAR; PG8_MMA(1, 0, At, B0); PG8_MMA(1, 1, At, B1); PG8_BAR; PG8_SCHED;
        }
        if constexpr (ALIGN_EPI) { if (wr == 0) PG8_BAR; }
        { int l2 = threadIdx.x; asm volatile("" : "+v"(l2)); E(acc, cur, wr, wc, l2 & 15, (l2 >> 4) & 3); }
        if (!has_next) break;
#pragma unroll
        for (int a = 0; a < 2; ++a)
#pragma unroll
            for (int b = 0; b < 2; ++b)
#pragma unroll
                for (int m = 0; m < 4; ++m)
#pragma unroll
                    for (int n = 0; n < 2; ++n) acc[a][b][m][n] = (f32x4){0.f, 0.f, 0.f, 0.f};
        cur = nxt; cA = nA; cB = nB; ++ui;
        if constexpr (ALIGN_EPI) { if (wr == 1) PG8_BAR; }
    }
    PG8_WAIT_V(0);
    if constexpr (!ALIGN_EPI) { if (wr == 0) PG8_BAR; }
    PG8_BAR;
#undef PG8_SA
#undef PG8_SB
#undef PG8_STAGE
#undef PG8_LDA
#undef PG8_LDB
#undef PG8_MMA
#undef PG8_WAIT_V
#undef PG8_WAIT_L
#undef PG8_BAR
#undef PG8_SCHED
}

typedef f32x4 Acc[2][2][4][2];
__device__ __forceinline__ float sigmoidf(float x) { return __builtin_amdgcn_rcpf(1.f + __builtin_amdgcn_exp2f(-1.4426950408889634f * x)); }
__device__ __forceinline__ float gelu_tanh(float x) { const float z = 0.7978845608028654f * (x + 0.044715f * x * x * x); return x * sigmoidf(2.f * z); }
__device__ __forceinline__ u32x4 pack8(const f32x4 a, const f32x4 b) { u32x4 w; w.x = pk2(a[0], a[1]); w.y = pk2(a[2], a[3]); w.z = pk2(b[0], b[1]); w.w = pk2(b[2], b[3]); return w; }

template <class T> __device__ __forceinline__ T* gp(const void* base, unsigned byteoff) { return (T*)((char*)base + byteoff); }
struct EpiSwiGLU {
    bf16_t* H;
    __device__ __forceinline__ void operator()(const Acc& acc, const Unit& u, int wr, int wc, int fr, int fq) const {
        const int row0 = u.pm * BM + wr * 64 + fr, hid = u.pn * 128 + wc * 32 + 8 * fq;
        const unsigned off0 = (unsigned)(row0 * FF + hid) * 2u;
#pragma unroll
        for (int ai = 0; ai < 2; ++ai)
#pragma unroll
            for (int m = 0; m < 4; ++m) {
                f32x4 o[2];
#pragma unroll
                for (int n = 0; n < 2; ++n)
#pragma unroll
                    for (int j = 0; j < 4; ++j) { const float gt = acc[ai][0][m][n][j], up = acc[ai][1][m][n][j]; o[n][j] = gt * sigmoidf(gt) * up; }
                *gp<u32x4>(H, off0 + (unsigned)((ai * HALF + m * 16) * FF) * 2u) = pack8(o[0], o[1]);
            }
    }
};
struct EpiResid {
    const float* x0; const float* x1; float* out; float s;
    __device__ __forceinline__ void operator()(const Acc& acc, const Unit& u, int wr, int wc, int fr, int fq) const {
        const int row0 = u.pm * BM + wr * 64 + fr, col0 = u.pn * BM + wc * 32 + 8 * fq;
        const bool lo = u.pm * BM < MP;
        const float* xb = lo ? x0 : x1;
        const unsigned xoff0 = (unsigned)((lo ? row0 : row0 - MP) * DM + col0) * 4u, ooff0 = (unsigned)(row0 * DM + col0) * 4u;
#pragma unroll
        for (int ai = 0; ai < 2; ++ai)
#pragma unroll
            for (int m = 0; m < 4; ++m) {
                const unsigned d = (unsigned)((ai * HALF + m * 16) * DM) * 4u;
#pragma unroll
                for (int bj = 0; bj < 2; ++bj) {
                    const f32x4 a = *gp<const f32x4>(xb, xoff0 + d + bj * HALF * 4), b = *gp<const f32x4>(xb, xoff0 + d + bj * HALF * 4 + 16);
                    *gp<f32x4>(out, ooff0 + d + bj * HALF * 4) = a * ALPHA + acc[ai][bj][m][0] * s;
                    *gp<f32x4>(out, ooff0 + d + bj * HALF * 4 + 16) = b * ALPHA + acc[ai][bj][m][1] * s;
                }
            }
    }
};
struct EpiWin {
    bf16_t* UEXT; bf16_t* PHY;
    __device__ __forceinline__ void operator()(const Acc& acc, const Unit& u, int wr, int wc, int fr, int fq) const {
        const int row0 = u.pm * BM + wr * 64 + fr, col0 = u.pn * BM + wc * 32 + 8 * fq;
        if (u.pn < 2) {
#pragma unroll
            for (int ai = 0; ai < 2; ++ai)
#pragma unroll
                for (int m = 0; m < 4; ++m) {
                    const int row = row0 + ai * HALF + m * 16, chunk = row >> 4, tl = row & 15;
#pragma unroll
                    for (int bj = 0; bj < 2; ++bj) { const int c0 = col0 + bj * HALF, g = c0 >> 4, h0 = c0 & 15;
                        *gp<u32x4>(UEXT, (unsigned)((g * NCHUNK + chunk) * 512 + tl * 16 + h0) * 2u) = pack8(acc[ai][bj][m][0], acc[ai][bj][m][1]); }
                }
        } else {
            const unsigned off0 = (unsigned)((col0 - 512) * MT + row0) * 2u;
#pragma unroll
            for (int bj = 0; bj < 2; ++bj)
#pragma unroll
                for (int n = 0; n < 2; ++n)
#pragma unroll
                    for (int j = 0; j < 4; ++j) {
                        const unsigned co = off0 + (unsigned)((bj * HALF + 4 * n + j) * MT) * 2u;
#pragma unroll
                        for (int ai = 0; ai < 2; ++ai)
#pragma unroll
                            for (int m = 0; m < 4; m += 2) { const unsigned pr = pk2(acc[ai][bj][m][n][j], acc[ai][bj][m + 1][n][j]);
                                *gp<bf16_t>(PHY, co + (unsigned)(ai * HALF + m * 16) * 2u) = (bf16_t)(pr & 0xffffu); *gp<bf16_t>(PHY, co + (unsigned)(ai * HALF + m * 16 + 16) * 2u) = (bf16_t)(pr >> 16); }
                    }
        }
    }
};
struct EpiS {
    float* S;
    __device__ __forceinline__ void operator()(const Acc& acc, const Unit& u, int wr, int wc, int fr, int fq) const {
        const int row0 = u.pm * BM + wr * 64 + fr, col0 = wc * 32 + 8 * fq;
        const unsigned off0 = (unsigned)(row0 * 256 + col0) * 4u;
#pragma unroll
        for (int ai = 0; ai < 2; ++ai)
#pragma unroll
            for (int m = 0; m < 4; ++m) { const unsigned d = off0 + (unsigned)((ai * HALF + m * 16) * 256) * 4u;
#pragma unroll
                for (int bj = 0; bj < 2; ++bj) { *gp<f32x4>(S, d + bj * HALF * 4) = acc[ai][bj][m][0]; *gp<f32x4>(S, d + bj * HALF * 4 + 16) = acc[ai][bj][m][1]; } }
    }
};
struct EpiY {
    bf16_t* G;
    __device__ __forceinline__ void operator()(const Acc& acc, const Unit& u, int wr, int wc, int fr, int fq) const {
        const int g = u.pn, row0 = u.pm * BM + wr * 64 + fr - g * NCHUNK, col0 = wc * 32 + 8 * fq;
#pragma unroll
        for (int ai = 0; ai < 2; ++ai)
#pragma unroll
            for (int m = 0; m < 4; ++m) { const int chunk = row0 + ai * HALF + m * 16;
#pragma unroll
                for (int bj = 0; bj < 2; ++bj) { const int col = col0 + bj * HALF, t = col >> 4, h0 = col & 15;
                    f32x4 o[2];
#pragma unroll
                    for (int n = 0; n < 2; ++n)
#pragma unroll
                        for (int j = 0; j < 4; ++j) o[n][j] = gelu_tanh(acc[ai][bj][m][n][j]);
                    *gp<u32x4>(G, (unsigned)((chunk * 16 + t) * 512 + g * 16 + h0) * 2u) = pack8(o[0], o[1]); } }
    }
};
struct EpiGLU {
    const bf16_t* G; const float* bias; bf16_t* Y;
    __device__ __forceinline__ void operator()(const Acc& acc, const Unit& u, int wr, int wc, int fr, int fq) const {
        const int row0 = u.pm * BM + wr * 64 + fr, col0 = u.pn * BM + wc * 32 + 8 * fq;
#pragma unroll
        for (int bj = 0; bj < 2; ++bj) { const int col = col0 + bj * HALF;
            const f32x4 b0 = *(const f32x4*)(bias + col), b1 = *(const f32x4*)(bias + col + 4);
#pragma unroll
            for (int ai = 0; ai < 2; ++ai)
#pragma unroll
                for (int m = 0; m < 4; ++m) { const unsigned off = (unsigned)((row0 + ai * HALF + m * 16) * 512 + col) * 2u;
                    const u32x4 gv = *gp<const u32x4>(G, off);
                    const float gg[8] = {bf_lo(gv.x), bf_hi(gv.x), bf_lo(gv.y), bf_hi(gv.y), bf_lo(gv.z), bf_hi(gv.z), bf_lo(gv.w), bf_hi(gv.w)};
                    f32x4 o[2];
#pragma unroll
                    for (int j = 0; j < 4; ++j) { o[0][j] = gg[j] * sigmoidf(acc[ai][bj][m][0][j] + b0[j]); o[1][j] = gg[4 + j] * sigmoidf(acc[ai][bj][m][1][j] + b1[j]); }
                    *gp<u32x4>(Y, off) = pack8(o[0], o[1]); } }
    }
};
}
using pg8::gp;

struct Params { const float* in[38]; float* out; unsigned char* ws; };
enum { I_XP = 0, I_XS, I_G1, I_U1, I_D1, I_LN1G, I_LN1B, I_WIN, I_LRE, I_LIM, I_LSTEP, I_BRE, I_BIM, I_CRE, I_CIM, I_SD, I_GLUW, I_GLUB, I_SNG,
       I_HSW, I_HSB, I_FW1, I_FB1, I_FW2, I_FB2, I_FW3, I_SFREQ, I_LDEC, I_HBIAS, I_HNG, I_WOUT, I_LN2G, I_LN2B, I_G2, I_U2, I_D2, I_LN3G, I_LN3B };

__device__ __forceinline__ void transpose_item(const float* W, int K, int N, bf16_t* WT, int k0, int n0, int dst_row0, LAS float* scr, int lane) {
#pragma unroll 8
    for (int i = 0; i < 32; ++i) { const int kk = 2 * i + (lane >> 5); scr[kk * 33 + (lane & 31)] = W[(size_t)(k0 + kk) * N + n0 + (lane & 31)]; }
    LDS_WAIT();
    const int c = lane & 7;
#pragma unroll
    for (int j = 0; j < 4; ++j) { const int n = (lane >> 3) + 8 * j; const LAS float* s = scr + (8 * c) * 33 + n;
        u32x4 o; o.x = pk2(s[0 * 33], s[1 * 33]); o.y = pk2(s[2 * 33], s[3 * 33]); o.z = pk2(s[4 * 33], s[5 * 33]); o.w = pk2(s[6 * 33], s[7 * 33]);
        *(u32x4*)(WT + (size_t)(dst_row0 + n) * K + k0 + 8 * c) = o; }
    LDS_WAIT();
}

__device__ __forceinline__ void transpose_job(const Params& P, int it, LAS float* scr, int lane) {
    unsigned char* ws = P.ws;
    const float* W; bf16_t* WT; int K, N, mode = 0;
    constexpr int I_GU = 16 * 88, I_D = 44 * 32, I_IN = 16 * 64, I_GL = 8 * 16, I_O = 16 * 32;
    int r = it;
    if (r < I_GU) { W = P.in[I_G1]; WT = (bf16_t*)(ws + WS_WGU1); K = DM; N = FF; mode = 1; }
    else if ((r -= I_GU) < I_GU) { W = P.in[I_U1]; WT = (bf16_t*)(ws + WS_WGU1); K = DM; N = FF; mode = 2; }
    else if ((r -= I_GU) < I_D) { W = P.in[I_D1]; WT = (bf16_t*)(ws + WS_WD1); K = FF; N = DM; }
    else if ((r -= I_D) < I_IN) { W = P.in[I_WIN]; WT = (bf16_t*)(ws + WS_WIN); K = DM; N = DIN; }
    else if ((r -= I_IN) < I_GL) { W = P.in[I_GLUW]; WT = (bf16_t*)(ws + WS_WGLU); K = 512; N = 512; }
    else if ((r -= I_GL) < I_O) { W = P.in[I_WOUT]; WT = (bf16_t*)(ws + WS_WOUT); K = DM; N = DM; }
    else if ((r -= I_O) < I_GU) { W = P.in[I_G2]; WT = (bf16_t*)(ws + WS_WGU2); K = DM; N = FF; mode = 1; }
    else if ((r -= I_GU) < I_GU) { W = P.in[I_U2]; WT = (bf16_t*)(ws + WS_WGU2); K = DM; N = FF; mode = 2; }
    else { r -= I_GU; W = P.in[I_D2]; WT = (bf16_t*)(ws + WS_WD2); K = FF; N = DM; }
    const int nblk = N / 32, kb = r / nblk, nb = r % nblk, k0 = 64 * kb, n0 = 32 * nb;
    const int dst = mode ? (256 * (n0 >> 7) + (n0 & 127) + (mode == 2 ? 128 : 0)) : n0;
    transpose_item(W, K, N, WT, k0, n0, dst, scr, lane);
}
constexpr int N_TRANSPOSE_ITEMS = 6 * 1408 + 1024 + 128 + 512;

__device__ __forceinline__ void filt_raw_item(LAS float* sm, const Params& P, int item, int tid) {
    LAS float* feats = sm;
    LAS float* h1 = sm + 640;
    LAS float* h2 = sm + 640 + 2048;
    const int t0 = item * 32;
    for (int fi = tid; fi < 32 * 17; fi += NTHREADS) { const int tt = fi / 17, f = fi % 17; const int t = t0 + tt; float v;
        if (f == 0) v = (float)t * (1.0f / 4096.0f);
        else { const int k = (f - 1) & 7; const float om = ((k & 1) ? 0.31622776601683794f : 1.0f) * ((k >> 1) == 0 ? 1.0f : (k >> 1) == 1 ? 0.1f : (k >> 1) == 2 ? 0.01f : 0.001f);
            const float p = (float)t * om, e = fmaf((float)t, om, -p); const float kk = rintf(p * 0.15915494309189535f);
            float r = fmaf(-kk, 6.28125f, p); r = fmaf(-kk, 1.9353071795864769e-3f, r) + e; v = (f <= 8) ? sinf(r) : cosf(r); }
        feats[tt * 20 + f] = v; }
    __syncthreads();
    const float* w1 = P.in[I_FW1]; const float* b1 = P.in[I_FB1]; const float* w2 = P.in[I_FW2]; const float* b2 = P.in[I_FB2]; const float* sf = P.in[I_SFREQ];
    for (int idx = tid; idx < 2048; idx += NTHREADS) { const int tt = idx >> 6, k = idx & 63; float s = b1[k];
#pragma unroll
        for (int f = 0; f < 17; ++f) s += feats[tt * 20 + f] * w1[f * 64 + k];
        h1[idx] = sinf(sf[k] * s); }
    __syncthreads();
    for (int idx = tid; idx < 2048; idx += NTHREADS) { const int tt = idx >> 6, k = idx & 63; float s = b2[k];
        for (int f = 0; f < 64; ++f) s += h1[tt * 64 + f] * w2[f * 64 + k];
        h2[idx] = sinf(sf[64 + k] * s); }
    __syncthreads();
    const int n = tid * 4; const float* w3 = P.in[I_FW3];
    const f32x4 ld = *(const f32x4*)(P.in[I_LDEC] + n);
    f32x4 rate; rate[0] = expf(ld[0]); rate[1] = expf(ld[1]); rate[2] = expf(ld[2]); rate[3] = expf(ld[3]);
    const bool bwd = ((n >> 9) & 1) != 0;
    float* FRAW = (float*)(P.ws + WS_FRAW);
    f32x4 asum = (f32x4){0.f, 0.f, 0.f, 0.f};
#pragma unroll 1
    for (int hf = 0; hf < 2; ++hf) {
        f32x4 acc[16];
#pragma unroll
        for (int tt = 0; tt < 16; ++tt) acc[tt] = (f32x4){0.f, 0.f, 0.f, 0.f};
#pragma unroll 1
        for (int k = 0; k < 64; k += 4) {
            const f32x4 wa = *(const f32x4*)(w3 + (size_t)(k + 0) * 2048 + n), wb = *(const f32x4*)(w3 + (size_t)(k + 1) * 2048 + n),
                        wc = *(const f32x4*)(w3 + (size_t)(k + 2) * 2048 + n), wd = *(const f32x4*)(w3 + (size_t)(k + 3) * 2048 + n);
#pragma unroll
            for (int tt = 0; tt < 16; ++tt) { const f32x4 hv = *(const LAS f32x4*)(h2 + (hf * 16 + tt) * 64 + k); acc[tt] += wa * hv[0] + wb * hv[1] + wc * hv[2] + wd * hv[3]; }
        }
#pragma unroll
        for (int tt = 0; tt < 16; ++tt) { const int t = t0 + hf * 16 + tt; const float tl = (float)t * (1.0f / 4096.0f);
            f32x4 v; v[0] = acc[tt][0] * expf(-tl * rate[0]); v[1] = acc[tt][1] * expf(-tl * rate[1]); v[2] = acc[tt][2] * expf(-tl * rate[2]); v[3] = acc[tt][3] * expf(-tl * rate[3]);
            *(f32x4*)(FRAW + (size_t)t * 2048 + n) = v;
            if (!(bwd && t == 0)) { asum[0] += fabsf(v[0]); asum[1] += fabsf(v[1]); asum[2] += fabsf(v[2]); asum[3] += fabsf(v[3]); } }
    }
    *(f32x4*)((float*)(P.ws + WS_PART) + (size_t)item * 2048 + n) = asum;
    __syncthreads();
}

__device__ __forceinline__ void s5_mats(LAS float* sm, const Params& P, int g, int tid) {
    LAS float* POWr = sm;
    LAS float* POWi = sm + 2176;
    LAS float* BBr = sm + 4352;
    LAS float* BBi = BBr + 2048;
    LAS float* Cr = BBi + 2048;
    LAS float* Ci = Cr + 2048;
    LAS float* Kt = Ci + 2048;
    const float* lre = P.in[I_LRE]; const float* lim = P.in[I_LIM]; const float* lst = P.in[I_LSTEP];
    for (int idx = tid; idx < 2176; idx += NTHREADS) { const int dir = idx / 1088, rem = idx % 1088, n = rem >> 6, p = rem & 63;
        const float step = expf(lst[dir * 32 + g]); const float lr = lre[(dir * 32 + g) * 64 + p], li = lim[(dir * 32 + g) * 64 + p];
        const float mag = expf(lr * step * (float)n), ang = li * step * (float)n;
        POWr[idx] = mag * cosf(ang); POWi[idx] = mag * sinf(ang); }
    for (int idx = tid; idx < 2048; idx += NTHREADS) { const int dir = idx >> 10, h = (idx >> 6) & 15, p = idx & 63;
        Cr[idx] = P.in[I_CRE][((size_t)(dir * 32 + g) * 16 + h) * 64 + p]; Ci[idx] = P.in[I_CIM][((size_t)(dir * 32 + g) * 16 + h) * 64 + p]; }
    __syncthreads();
    for (int idx = tid; idx < 2048; idx += NTHREADS) { const int dir = idx >> 10, p = (idx >> 4) & 63, h = idx & 15;
        const float lr = lre[(dir * 32 + g) * 64 + p], li = lim[(dir * 32 + g) * 64 + p];
        const float ar = POWr[dir * 1088 + 64 + p], ai = POWi[dir * 1088 + 64 + p];
        const float nr = ar - 1.0f, ni = ai, den = lr * lr + li * li;
        const float qr = (nr * lr + ni * li) / den, qi = (ni * lr - nr * li) / den;
        const float br = P.in[I_BRE][((size_t)(dir * 32 + g) * 64 + p) * 16 + h], bi = P.in[I_BIM][((size_t)(dir * 32 + g) * 64 + p) * 16 + h];
        BBr[idx] = qr * br - qi * bi; BBi[idx] = qr * bi + qi * br; }
    __syncthreads();
    for (int idx = tid; idx < 8192; idx += NTHREADS) { const int dir = idx >> 12, n = (idx >> 8) & 15, h = (idx >> 4) & 15, h2 = idx & 15; float s = 0.f;
        for (int p = 0; p < 64; ++p) { const float cr = Cr[dir * 1024 + h * 64 + p], ci = Ci[dir * 1024 + h * 64 + p], pr = POWr[dir * 1088 + n * 64 + p], pi = POWi[dir * 1088 + n * 64 + p];
            const float tr = cr * pr - ci * pi, ti = cr * pi + ci * pr; s += tr * BBr[dir * 1024 + p * 16 + h2] - ti * BBi[dir * 1024 + p * 16 + h2]; }
        Kt[idx] = s; }
    __syncthreads();
    bf16_t* WMAT = (bf16_t*)(P.ws + WS_WMAT) + (size_t)g * 256 * 512;
    bf16_t* WEND = (bf16_t*)(P.ws + WS_WEND) + (size_t)g * 256 * 256;
    const float* sd = P.in[I_SD] + g * 16;
    for (int idx = tid; idx < 256 * 256; idx += NTHREADS) {
        const int row = idx >> 8, col = (idx & 255) * 2, t = row >> 4, h = row & 15; float v[2];
#pragma unroll
        for (int e = 0; e < 2; ++e) { const int cc = col + e;
            if (cc < 256) { const int s = cc >> 4, h2 = cc & 15; float x = 0.f;
                if (s <= t) x += Kt[((0 * 16 + (t - s)) * 16 + h) * 16 + h2];
                if (s >= t) x += Kt[((1 * 16 + (s - t)) * 16 + h) * 16 + h2];
                if (s == t && h == h2) x += sd[h];
                v[e] = x; }
            else { const int c2 = cc - 256, dir = c2 >> 7, p = (c2 >> 1) & 63, ri = c2 & 1; const int ex = dir == 0 ? t + 1 : 16 - t;
                const float cr = Cr[dir * 1024 + h * 64 + p], ci = Ci[dir * 1024 + h * 64 + p], pr = POWr[dir * 1088 + ex * 64 + p], pi = POWi[dir * 1088 + ex * 64 + p];
                v[e] = ri == 0 ? (cr * pr - ci * pi) : -(cr * pi + ci * pr); } }
        *(unsigned*)(WMAT + (size_t)row * 512 + col) = pk2(v[0], v[1]); }
    for (int idx = tid; idx < 256 * 128; idx += NTHREADS) {
        const int row = idx >> 7, col = (idx & 127) * 2, dir = row >> 7, p = (row >> 1) & 63, ri = row & 1; float v[2];
#pragma unroll
        for (int e = 0; e < 2; ++e) { const int cc = col + e, s = cc >> 4, h2 = cc & 15; const int ex = dir == 0 ? 15 - s : s;
            const float pr = POWr[dir * 1088 + ex * 64 + p], pi = POWi[dir * 1088 + ex * 64 + p], br = BBr[dir * 1024 + p * 16 + h2], bi = BBi[dir * 1024 + p * 16 + h2];
            v[e] = ri == 0 ? (pr * br - pi * bi) : (pr * bi + pi * br); }
        *(unsigned*)(WEND + (size_t)row * 256 + col) = pk2(v[0], v[1]); }
    float* A16 = (float*)(P.ws + WS_SCAN);
    if (tid < 128) { const int dir = tid >> 6, p = tid & 63; A16[((g * 2 + dir) * 64 + p) * 2 + 0] = POWr[dir * 1088 + 16 * 64 + p]; A16[((g * 2 + dir) * 64 + p) * 2 + 1] = POWi[dir * 1088 + 16 * 64 + p]; }
    __syncthreads();
}

__device__ __forceinline__ void filt_norm_item(const Params& P, int it, LAS float* scr, int lane) {
    int ty, r = it;
    if (r < 1024) ty = 0; else { ty = 1; r -= 1024; }
    const int ntc = ty ? 4 : 16;
    const int tch = r % ntc; r /= ntc; const int ctile = r & 15; r >>= 4; const int dir = r & 1, o = r >> 1;
    const int L = ty ? LS : LP, RLEN = 2 * L + 64, C0 = L + 32, np = ty ? 64 : 256;
    const int cc = lane & 31, half = lane >> 5, c = ctile * 32 + cc, n = o * 1024 + dir * 512 + c;
    const float* PART = (const float*)(P.ws + WS_PART); const float* FRAW = (const float*)(P.ws + WS_FRAW);
    float s = 0.f;
    for (int i = 0; i < np; ++i) s += PART[(size_t)i * 2048 + o * 1024 + c] + PART[(size_t)i * 2048 + o * 1024 + 512 + c];
    const float inv = 1.0f / (s + FILTER_EPS);
    bf16_t* F = (bf16_t*)(P.ws + (ty ? WS_FS : WS_FP));
    for (int tt0 = tch * 512; tt0 < tch * 512 + 512; tt0 += 64) {
#pragma unroll 8
        for (int i = 0; i < 32; ++i) { const int tl = 2 * i + half; scr[tl * 33 + cc] = FRAW[(size_t)(tt0 + tl) * 2048 + n] * inv; }
        LDS_WAIT();
        const int t = tt0 + lane; const int idx = dir ? C0 + t : C0 - t; const bool wr = !(dir && t == 0);
        for (int c2 = 0; c2 < 32; ++c2) { const bf16_t v = (bf16_t)f2bf(scr[lane * 33 + c2]); bf16_t* dst = F + (size_t)(o * 512 + ctile * 32 + c2) * (2 * RLEN);
            if (wr) { dst[idx] = v; dst[RLEN + idx - 1] = v; } }
        LDS_WAIT();
    }
}
constexpr int N_FNORM_ITEMS = 1024 + 256;

__device__ __forceinline__ void ln_rows(float* X, bf16_t* XB, const float* gam, const float* bet, int gw, int ngw, int lane, bool wb) {
    f32x4 gv[4], bv[4];
#pragma unroll
    for (int j = 0; j < 4; ++j) { gv[j] = *(const f32x4*)(gam + 4 * lane + 256 * j); bv[j] = *(const f32x4*)(bet + 4 * lane + 256 * j); }
    for (int m = gw; m < MT; m += ngw) {
        float* xr = X + (size_t)m * DM + 4 * lane; f32x4 v[4]; float s = 0.f;
#pragma unroll
        for (int j = 0; j < 4; ++j) { v[j] = *(const f32x4*)(xr + 256 * j); s += (v[j][0] + v[j][1]) + (v[j][2] + v[j][3]); }
        const float mean = wave_sum(s) * (1.f / DM); float s2 = 0.f;
#pragma unroll
        for (int j = 0; j < 4; ++j) { v[j] = v[j] - mean; s2 += (v[j][0] * v[j][0] + v[j][1] * v[j][1]) + (v[j][2] * v[j][2] + v[j][3] * v[j][3]); }
        const float rstd = 1.f / sqrtf(wave_sum(s2) * (1.f / DM) + LN_EPS);
#pragma unroll
        for (int j = 0; j < 4; ++j) { const f32x4 o = v[j] * rstd * gv[j] + bv[j]; *(f32x4*)(xr + 256 * j) = o;
            if (wb) { u32x2 w; w.x = pk2(o[0], o[1]); w.y = pk2(o[2], o[3]); *(u32x2*)(XB + (size_t)m * DM + 4 * lane + 256 * j) = w; } }
    }
}

constexpr int ZERO_OFF = 131072;
#ifndef RING
#define RING 4
#endif
__device__ __forceinline__ u32x4 ld_filt(const bf16_t* p) { const U4A4 v = *(const U4A4*)p; u32x4 w; w.x = v.x; w.y = v.y; w.z = v.z; w.w = v.w; return w; }

constexpr int ZB = 4096;
template <int NB>
__device__ __forceinline__ void hyena_unit(LAS unsigned char* lds, const Params& P, int c, int ty) {
    constexpr int L = NB * 32, NT = NB / 32, RLEN = 2 * L + 64, C0 = L + 32, BPW = NB / 8, ZBYTES = NB * 8 * 64;
    constexpr int HB = 2;
    int tid_ = threadIdx.x; asm volatile("" : "+v"(tid_));
    const int tid = tid_, wave = __builtin_amdgcn_readfirstlane(tid >> 6), lane = tid & 63, n = lane & 31, hh = lane >> 5;
    const int tb = ty ? MP : 0;
    const bf16_t* PHY = (const bf16_t*)(P.ws + WS_H + 160 * MiB);
    bf16_t* YHY = (bf16_t*)(P.ws + WS_YHY);
    const bf16_t* FILT = (const bf16_t*)(P.ws + (ty ? WS_FS : WS_FP));
    const float* sw = P.in[I_HSW]; const float* sb = P.in[I_HSB];
    LAS unsigned char* Z = lds + ZB;
    {
        const bf16_t* pv = PHY + (size_t)c * MT + tb;
        const float w0 = sw[c], w1 = sw[1536 + c], w2 = sw[3072 + c], bb = sb[c];
        if (tid < 224) *(LAS u32x4*)(lds + ZB - 3584 + tid * 16) = (u32x4){0u, 0u, 0u, 0u};
        else if (tid < 448) *(LAS u32x4*)(lds + ZB + ZBYTES + (tid - 224) * 16) = (u32x4){0u, 0u, 0u, 0u};
#pragma unroll 4
        for (int ci = tid; ci < L; ci += NTHREADS) {
            const int b = ci / (L / 8), t0 = (ci % (L / 8)) * 8;
            const bf16_t* p = pv + (size_t)b * L + t0;
            const u32x4 raw = *(const u32x4*)p;
            float x[10];
            x[0] = t0 > 0 ? bf2f(p[-1]) : 0.f; x[9] = (t0 + 8 < L) ? bf2f(p[8]) : 0.f;
            x[1] = bf_lo(raw.x); x[2] = bf_hi(raw.x); x[3] = bf_lo(raw.y); x[4] = bf_hi(raw.y); x[5] = bf_lo(raw.z); x[6] = bf_hi(raw.z); x[7] = bf_lo(raw.w); x[8] = bf_hi(raw.w);
            float v[8];
#pragma unroll
            for (int e = 0; e < 8; ++e) v[e] = bb + w0 * x[e] + w1 * x[e + 1] + w2 * x[e + 2];
            u32x4 o; o.x = pk2(v[0], v[1]); o.y = pk2(v[2], v[3]); o.z = pk2(v[4], v[5]); o.w = pk2(v[6], v[7]);
            const int row = (t0 >> 5) * 8 + b, chunk = (t0 & 31) >> 3;
            *(LAS u32x4*)(Z + row * 64 + ((chunk ^ ((row >> 2) & 3)) << 4)) = o;
        }
    }
    __syncthreads();
    const int i_lo = wave * BPW;
    const int swE = (n >> 2) & 3, swO = ((n >> 2) + 2) & 3;
    const int offE0 = n * 64 + ((hh ^ swE) << 4), offE1 = n * 64 + (((2 + hh) ^ swE) << 4);
    const int offO0 = n * 64 + ((hh ^ swO) << 4), offO1 = n * 64 + (((2 + hh) ^ swO) << 4);
#pragma unroll 1
    for (int o = 0; o < 2; ++o) {
        const bf16_t* R0 = FILT + (size_t)(o * 512 + c) * (2 * RLEN);
        const int rl = ((n & 1) * (RLEN - 1) + (C0 - n + 8 * hh)) * 2;
        f32x16 acc[NT];
#pragma unroll
        for (int T = 0; T < NT; ++T)
#pragma unroll
            for (int e = 0; e < 16; ++e) acc[T][e] = 0.f;
        const int d0 = i_lo - (NB - 1); constexpr int nd = NB + BPW - 1;
        u32x4 ring[RING][2];
#pragma unroll
        for (int u = 0; u < RING; ++u) { ring[u][0] = ld_filt(gp<const bf16_t>(R0, (unsigned)(rl - 64 * (d0 + u)))); ring[u][1] = ld_filt(gp<const bf16_t>(R0, (unsigned)(rl - 64 * (d0 + u) + 32))); }
#define HY_ROTATE(dd) const bf16x8 A0 = __builtin_bit_cast(bf16x8, ring[0][0]), A1 = __builtin_bit_cast(bf16x8, ring[0][1]); _Pragma("unroll") for (int u = 0; u + 1 < RING; ++u) { ring[u][0] = ring[u + 1][0]; ring[u][1] = ring[u + 1][1]; } \
        if ((dd) + RING < nd) { ring[RING - 1][0] = ld_filt(gp<const bf16_t>(R0, (unsigned)(rl - 64 * (d0 + (dd) + RING)))); ring[RING - 1][1] = ld_filt(gp<const bf16_t>(R0, (unsigned)(rl - 64 * (d0 + (dd) + RING) + 32))); }
#define HY_EDGE(dd) { HY_ROTATE(dd) const int jb = i_lo - (d0 + (dd)); const int base0 = jb * 512 + ((jb & 1) ? offO0 : offE0), base1 = jb * 512 + ((jb & 1) ? offO1 : offE1); \
        _Pragma("unroll") for (int bi = 0; bi < NT / HB; ++bi) { const int j0 = jb + 4 * HB * bi; if (j0 > -4 * HB && j0 < NB) { bf16x8 be[2 * HB]; \
            _Pragma("unroll") for (int q = 0; q < HB; ++q) { be[2 * q] = *(const LAS bf16x8*)(Z + base0 + (bi * HB + q) * 2048); be[2 * q + 1] = *(const LAS bf16x8*)(Z + base1 + (bi * HB + q) * 2048); } \
            _Pragma("unroll") for (int q = 0; q < HB; ++q) acc[bi * HB + q] = __builtin_amdgcn_mfma_f32_32x32x16_bf16(A0, be[2 * q], acc[bi * HB + q], 0, 0, 0); \
            _Pragma("unroll") for (int q = 0; q < HB; ++q) acc[bi * HB + q] = __builtin_amdgcn_mfma_f32_32x32x16_bf16(A1, be[2 * q + 1], acc[bi * HB + q], 0, 0, 0); } } }
#pragma unroll 1
        for (int dd = 0; dd < BPW - 1; ++dd) HY_EDGE(dd)
        {
            constexpr int NBATCH = NT / HB;
            bf16x8 Bq[2][2 * HB];
#define HY_BASES(jb_) const int base0 = (jb_) * 512 + (((jb_) & 1) ? offO0 : offE0), base1 = (jb_) * 512 + (((jb_) & 1) ? offO1 : offE1)
#define HY_READ(buf, bi) _Pragma("unroll") for (int q = 0; q < HB; ++q) { Bq[buf][2 * q] = *(const LAS bf16x8*)(Z + base0 + ((bi) * HB + q) * 2048); Bq[buf][2 * q + 1] = *(const LAS bf16x8*)(Z + base1 + ((bi) * HB + q) * 2048); }
            { HY_BASES(i_lo - (d0 + BPW - 1)); HY_READ(0, 0) }
#pragma unroll 1
            for (int dd = BPW - 1; dd < NB; ++dd) {
                HY_ROTATE(dd)
                const int jb = i_lo - (d0 + dd);
#pragma unroll
                for (int bi = 0; bi < NBATCH; ++bi) {
                    if (bi + 1 < NBATCH) { HY_BASES(jb); HY_READ((bi + 1) & 1, bi + 1) }
                    else if (dd + 1 < NB) { HY_BASES(jb - 1); HY_READ((bi + 1) & 1, 0) }
#pragma unroll
                    for (int q = 0; q < HB; ++q) acc[bi * HB + q] = __builtin_amdgcn_mfma_f32_32x32x16_bf16(A0, Bq[bi & 1][2 * q], acc[bi * HB + q], 0, 0, 0);
#pragma unroll
                    for (int q = 0; q < HB; ++q) acc[bi * HB + q] = __builtin_amdgcn_mfma_f32_32x32x16_bf16(A1, Bq[bi & 1][2 * q + 1], acc[bi * HB + q], 0, 0, 0);
                }
                if constexpr (NBATCH & 1) {
#pragma unroll
                    for (int q = 0; q < 2 * HB; ++q) Bq[0][q] = Bq[1][q];
                }
            }
#undef HY_READ
#undef HY_BASES
        }
#pragma unroll 1
        for (int dd = NB; dd < nd; ++dd) HY_EDGE(dd)
#undef HY_EDGE
#undef HY_ROTATE
        __syncthreads();
        {
            int l3 = threadIdx.x; asm volatile("" : "+v"(l3));
            const int n3 = l3 & 31, h3 = (l3 >> 5) & 1;
            const int gch = 512 * (o + 1) + c;
            const bf16_t* pg = PHY + (size_t)gch * MT + tb;
            bf16_t* py = YHY + (size_t)c * MT + tb;
            const float w0 = sw[gch], w1 = sw[1536 + gch], w2 = sw[3072 + gch], bb = sb[gch];
            const float hb = P.in[I_HBIAS][o * 512 + c];
            const int b = n3 & 7;
            u32x2 graw[2][4]; float gxm[2][4], gxp[2][4];
#define HY_GLOAD(buf, T_) { const int ib_ = i_lo + 4 * (T_) + (n3 >> 3); _Pragma("unroll") for (int rg = 0; rg < 4; ++rg) { const int t = 32 * ib_ + 8 * rg + 4 * h3; const unsigned go = (unsigned)(b * L + t) * 2u; \
                graw[buf][rg] = *gp<const u32x2>(pg, go); gxm[buf][rg] = t > 0 ? bf2f(*gp<const bf16_t>(pg, go - 2u)) : 0.f; gxp[buf][rg] = (t + 4 < L) ? bf2f(*gp<const bf16_t>(pg, go + 8u)) : 0.f; } }
            HY_GLOAD(0, 0)
#pragma unroll
            for (int T = 0; T < NT; ++T) {
                const int ib = i_lo + 4 * T + (n3 >> 3), row = ib * 8 + b;
                if (T + 1 < NT) HY_GLOAD((T + 1) & 1, T + 1)
#pragma unroll
                for (int rg = 0; rg < 4; ++rg) {
                    const int t = 32 * ib + 8 * rg + 4 * h3;
                    const unsigned go = (unsigned)(b * L + t) * 2u;
                    const u32x2 raw = graw[T & 1][rg];
                    const float xm = gxm[T & 1][rg], xp = gxp[T & 1][rg];
                    const float x1 = bf_lo(raw.x), x2 = bf_hi(raw.x), x3 = bf_lo(raw.y), x4 = bf_hi(raw.y);
                    const float g0 = bb + w0 * xm + w1 * x1 + w2 * x2, g1 = bb + w0 * x1 + w1 * x2 + w2 * x3, g2 = bb + w0 * x2 + w1 * x3 + w2 * x4, g3 = bb + w0 * x3 + w1 * x4 + w2 * xp;
                    const int za = row * 64 + ((rg ^ ((row >> 2) & 3)) << 4) + 8 * h3;
                    const u32x2 zr = *(const LAS u32x2*)(Z + za);
                    const float z0 = g0 * (acc[T][4 * rg + 0] + hb * bf_lo(zr.x)), z1 = g1 * (acc[T][4 * rg + 1] + hb * bf_hi(zr.x)),
                                z2 = g2 * (acc[T][4 * rg + 2] + hb * bf_lo(zr.y)), z3 = g3 * (acc[T][4 * rg + 3] + hb * bf_hi(zr.y));
                    u32x2 w; w.x = pk2(z0, z1); w.y = pk2(z2, z3);
                    if (o == 0) *(LAS u32x2*)(Z + za) = w;
                    else *gp<u32x2>(py, go) = w;
                }
                __builtin_amdgcn_sched_barrier(0);
            }
#undef HY_GLOAD
        }
        __syncthreads();
    }
}

#ifndef PHMASK
#define PHMASK 0xFFFFFF
#endif
#ifndef REPMASK
#define REPMASK 0
#endif
#define PH(k) for (int rep_ = 0; rep_ < 1 + ((REPMASK >> (k)) & 1); ++rep_) if constexpr ((PHMASK >> (k)) & 1)
#define FRESH() int tid_ = threadIdx.x; asm volatile("" : "+v"(tid_)); const int tid = tid_, lane = tid & 63, wave = __builtin_amdgcn_readfirstlane(tid >> 6); \
    const int gw = bx * NWAVES + wave; unsigned char* ws = P.ws; asm volatile("" : "+s"(ws)); (void)lane; (void)gw; (void)tid
__global__ void __launch_bounds__(NTHREADS, 2) mega_fwd(Params P) {
    extern __shared__ __attribute__((aligned(16))) unsigned char lds_raw[];
    LAS unsigned char* lds = (LAS unsigned char*)lds_raw;
    cg::grid_group grid = cg::this_grid();
    const int G = gridDim.x, bx = blockIdx.x, NGW = G * NWAVES;

    PH(16) { FRESH(); for (int it = bx; it < 256; it += G) filt_raw_item((LAS float*)lds, P, it, tid); }
    PH(17) { FRESH(); for (int g = bx; g < 32; g += G) s5_mats((LAS float*)lds, P, g, tid); }
    PH(0) { FRESH();
        LAS float* scr = (LAS float*)(lds + wave * 16384);
        for (int it = gw; it < N_TRANSPOSE_ITEMS; it += NGW) transpose_job(P, it, scr, lane);
        bf16_t* XB = (bf16_t*)(ws + WS_XB);
        for (int m = gw; m < MT; m += NGW) {
            const float* xr = (m < MP ? P.in[I_XP] + (size_t)m * DM : P.in[I_XS] + (size_t)(m - MP) * DM) + 4 * lane;
#pragma unroll
            for (int j = 0; j < 4; ++j) { const f32x4 v = *(const f32x4*)(xr + 256 * j); u32x2 w; w.x = pk2(v[0], v[1]); w.y = pk2(v[2], v[3]); *(u32x2*)(XB + (size_t)m * DM + 4 * lane + 256 * j) = w; }
        }
    }
    grid.sync();
    PH(1) { FRESH(); pg8::Gemm g{(bf16_t*)(ws + WS_XB), (const bf16_t*)(ws + WS_WGU1), DM, DM, DM}; pg8::StaticOrder So; So.init(MT, 2 * FF, G, bx); pg8::EpiSwiGLU E{(bf16_t*)(ws + WS_H)};
      pg8::gemm_phase<pg8::EpiSwiGLU, pg8::StaticOrder, true>(lds, g, So, E); }
    grid.sync();
    PH(2) { FRESH(); pg8::Gemm g{(bf16_t*)(ws + WS_H), (const bf16_t*)(ws + WS_WD1), FF, FF, FF}; pg8::StaticOrder So; So.init(MT, DM, G, bx); pg8::EpiResid E{P.in[I_XP], P.in[I_XS], P.out, 0.5f};
      pg8::gemm_phase<pg8::EpiResid, pg8::StaticOrder, true>(lds, g, So, E); }
    grid.sync();
    PH(3) { FRESH(); ln_rows(P.out, (bf16_t*)(ws + WS_XB), P.in[I_LN1G], P.in[I_LN1B], gw, NGW, lane, true); }
    PH(18) { FRESH(); LAS float* scr = (LAS float*)(lds + wave * 16384);
      for (int it = gw; it < N_FNORM_ITEMS; it += NGW) filt_norm_item(P, it, scr, lane); }
    grid.sync();
    PH(4) { FRESH(); pg8::Gemm g{(bf16_t*)(ws + WS_XB), (const bf16_t*)(ws + WS_WIN), DM, DM, DM}; pg8::StaticOrder So; So.init(MT, DIN, G, bx); pg8::EpiWin E{(bf16_t*)(ws + WS_H), (bf16_t*)(ws + WS_H + 160 * MiB)};
      pg8::gemm_phase<pg8::EpiWin, pg8::StaticOrder, true>(lds, g, So, E); }
    grid.sync();
    PH(5) { FRESH(); pg8::Gemm g{(bf16_t*)(ws + WS_H), (const bf16_t*)(ws + WS_WEND), 256, 512, 256}; pg8::GroupOrder So{G, bx}; pg8::EpiS E{(float*)(ws + WS_XB)};
      pg8::gemm_phase<pg8::EpiS, pg8::GroupOrder, true>(lds, g, So, E); }
    grid.sync();
    PH(6) { FRESH();
        const float* A16 = (const float*)(ws + WS_SCAN); const float* S = (const float*)(ws + WS_XB); bf16_t* UEXT = (bf16_t*)(ws + WS_H);
        for (int id = wave * G + bx; id < 1024; id += NGW) {
            const int ty = id >> 9, rest = id & 511, b = rest >> 6, g = (rest >> 1) & 31, dir = rest & 1;
            const int NC = ty ? 128 : 512, cbase = ty ? 4096 + b * 128 : b * 512;
            const float ar = A16[((g * 2 + dir) * 64 + lane) * 2], ai = A16[((g * 2 + dir) * 64 + lane) * 2 + 1];
            const f32x2* Sp = (const f32x2*)(S + (size_t)(g * NCHUNK + cbase) * 256 + dir * 128) + lane;
            unsigned* Hp = (unsigned*)(UEXT + (size_t)(g * NCHUNK + cbase) * 512 + 256 + dir * 128) + lane;
            float hr = 0.f, hi = 0.f;
            for (int c0 = 0; c0 < NC; c0 += 8) {
                f32x2 s[8];
#pragma unroll
                for (int k = 0; k < 8; ++k) { const int ci = dir ? NC - 1 - (c0 + k) : c0 + k; s[k] = Sp[(size_t)ci * 128]; }
#pragma unroll
                for (int k = 0; k < 8; ++k) { const int ci = dir ? NC - 1 - (c0 + k) : c0 + k; Hp[(size_t)ci * 256] = pk2(hr, hi);
                    const float nr = ar * hr - ai * hi + s[k][0], ni = ar * hi + ai * hr + s[k][1]; hr = nr; hi = ni; }
            }
        }
    }
    grid.sync();
    PH(7) { FRESH(); pg8::Gemm g{(bf16_t*)(ws + WS_H), (const bf16_t*)(ws + WS_WMAT), 512, 512, 512}; pg8::GroupOrder So{G, bx}; pg8::EpiY E{(bf16_t*)(ws + WS_XB)};
      pg8::gemm_phase<pg8::EpiY, pg8::GroupOrder, true>(lds, g, So, E); }
    grid.sync();
    PH(8) { FRESH(); pg8::Gemm g{(bf16_t*)(ws + WS_XB), (const bf16_t*)(ws + WS_WGLU), 512, 512, 512}; pg8::StaticOrder So; So.init(MT, 512, G, bx); pg8::EpiGLU E{(bf16_t*)(ws + WS_XB), P.in[I_GLUB], (bf16_t*)(ws + WS_XB + 80 * MiB)};
      pg8::gemm_phase<pg8::EpiGLU, pg8::StaticOrder, true>(lds, g, So, E); }
    PH(9) {
#pragma unroll 1
        for (int u = bx; u < 512; u += G) hyena_unit<256>(lds, P, u, 0);
#pragma unroll 1
        for (int u = bx; u < 512; u += G) hyena_unit<64>(lds, P, u, 1);
    }
    grid.sync();
    PH(10) { FRESH();
        const float* sng = P.in[I_SNG]; const float* hng = P.in[I_HNG];
        const bf16_t* YHY = (const bf16_t*)(ws + WS_YHY); const bf16_t* YSSM = (const bf16_t*)(ws + WS_XB + 80 * MiB); bf16_t* MIXED = (bf16_t*)(ws + WS_H);
        LAS unsigned* tile = (LAS unsigned*)lds;
        for (int tl = bx; tl < MT / 64; tl += G) {
            const int tok0 = tl * 64;
            for (int ci = tid; ci < 512 * 8; ci += NTHREADS) { const int c = ci >> 3, q = ci & 7; const u32x4 v = *(const u32x4*)(YHY + (size_t)c * MT + tok0 + q * 8);
                tile[c * 33 + q * 4 + 0] = v.x; tile[c * 33 + q * 4 + 1] = v.y; tile[c * 33 + q * 4 + 2] = v.z; tile[c * 33 + q * 4 + 3] = v.w; }
            for (int r = 0; r < 8; ++r) { const int tok = tok0 + wave * 8 + r;
                const u32x4 v = *(const u32x4*)(YSSM + (size_t)tok * 512 + 8 * lane);
                float x[8] = {bf_lo(v.x), bf_hi(v.x), bf_lo(v.y), bf_hi(v.y), bf_lo(v.z), bf_hi(v.z), bf_lo(v.w), bf_hi(v.w)}; float ss = 0.f;
#pragma unroll
                for (int e = 0; e < 8; ++e) ss += x[e] * x[e];
                const float sc = 1.f / sqrtf(wave_sum(ss) * (1.f / 512.f) + RMS_EPS);
                const f32x4 g0 = *(const f32x4*)(sng + 8 * lane), g1 = *(const f32x4*)(sng + 8 * lane + 4);
                u32x4 w; w.x = pk2(x[0] * sc * g0[0], x[1] * sc * g0[1]); w.y = pk2(x[2] * sc * g0[2], x[3] * sc * g0[3]); w.z = pk2(x[4] * sc * g1[0], x[5] * sc * g1[1]); w.w = pk2(x[6] * sc * g1[2], x[7] * sc * g1[3]);
                *(u32x4*)(MIXED + (size_t)tok * DM + 8 * lane) = w; }
            __syncthreads();
            for (int r = 0; r < 4; ++r) { const int tp = wave * 4 + r; float xa[8], xb[8], sa = 0.f, sb2 = 0.f;
#pragma unroll
                for (int k = 0; k < 8; ++k) { const unsigned v = tile[(lane + 64 * k) * 33 + tp]; xa[k] = bf_lo(v); xb[k] = bf_hi(v); sa += xa[k] * xa[k]; sb2 += xb[k] * xb[k]; }
                const float sca = 1.f / sqrtf(wave_sum(sa) * (1.f / 512.f) + RMS_EPS), scb = 1.f / sqrtf(wave_sum(sb2) * (1.f / 512.f) + RMS_EPS);
                bf16_t* oa = MIXED + (size_t)(tok0 + 2 * tp) * DM + 512; bf16_t* ob = oa + DM;
#pragma unroll
                for (int k = 0; k < 8; ++k) { const float gg = hng[lane + 64 * k]; const unsigned pr = pk2(xa[k] * sca * gg, xb[k] * scb * gg); oa[lane + 64 * k] = (bf16_t)(pr & 0xffffu); ob[lane + 64 * k] = (bf16_t)(pr >> 16); } }
            __syncthreads();
        }
    }
    grid.sync();
    PH(11) { FRESH(); pg8::Gemm g{(bf16_t*)(ws + WS_H), (const bf16_t*)(ws + WS_WOUT), DM, DM, DM}; pg8::StaticOrder So; So.init(MT, DM, G, bx); pg8::EpiResid E{P.out, P.out + (size_t)MP * DM, P.out, 1.0f};
      pg8::gemm_phase<pg8::EpiResid, pg8::StaticOrder, true>(lds, g, So, E); }
    grid.sync();
    PH(12) { FRESH(); ln_rows(P.out, (bf16_t*)(ws + WS_XB), P.in[I_LN2G], P.in[I_LN2B], gw, NGW, lane, true); }
    grid.sync();
    PH(13) { FRESH(); pg8::Gemm g{(bf16_t*)(ws + WS_XB), (const bf16_t*)(ws + WS_WGU2), DM, DM, DM}; pg8::StaticOrder So; So.init(MT, 2 * FF, G, bx); pg8::EpiSwiGLU E{(bf16_t*)(ws + WS_H)};
      pg8::gemm_phase<pg8::EpiSwiGLU, pg8::StaticOrder, true>(lds, g, So, E); }
    grid.sync();
    PH(14) { FRESH(); pg8::Gemm g{(bf16_t*)(ws + WS_H), (const bf16_t*)(ws + WS_WD2), FF, FF, FF}; pg8::StaticOrder So; So.init(MT, DM, G, bx); pg8::EpiResid E{P.out, P.out + (size_t)MP * DM, P.out, 0.5f};
      pg8::gemm_phase<pg8::EpiResid, pg8::StaticOrder, true>(lds, g, So, E); }
    grid.sync();
    PH(15) { FRESH(); ln_rows(P.out, (bf16_t*)(ws + WS_XB), P.in[I_LN3G], P.in[I_LN3B], gw, NGW, lane, false); }
}

extern "C" void kernel_launch(void* const* d_in, const int* in_sizes, int n_in, void* d_out, int out_size, void* d_ws, size_t ws_size, hipStream_t stream) {
    static int grid = 0;
    if (grid == 0) {
        if (n_in != 38 || out_size != MT * DM || ws_size < WS_END) { fprintf(stderr, "kernel_launch: unexpected problem: n_in %d out %d ws %zu (need %zu)\n", n_in, out_size, ws_size, (size_t)WS_END); grid = -1; return; }
        int dev = 0, cus = 0, per_cu = 0;
        hipGetDevice(&dev);
        hipDeviceGetAttribute(&cus, hipDeviceAttributeMultiprocessorCount, dev);
        hipFuncSetAttribute((const void*)mega_fwd, hipFuncAttributeMaxDynamicSharedMemorySize, LDS_BYTES);
        hipOccupancyMaxActiveBlocksPerMultiprocessor(&per_cu, (const void*)mega_fwd, NTHREADS, LDS_BYTES);
        if (per_cu < 1) { fprintf(stderr, "kernel_launch: occupancy query says %d blocks per CU\n", per_cu); per_cu = 1; }
        (void)hipGetLastError();
        grid = cus * per_cu;
        fprintf(stderr, "kernel_launch: grid %d (cus %d x %d)\n", grid, cus, per_cu);
    }
    if (grid < 0) return;
    Params p{};
    for (int i = 0; i < 38; ++i) p.in[i] = (const float*)d_in[i];
    p.out = (float*)d_out; p.ws = (unsigned char*)d_ws;
    void* args[] = {&p};
    hipError_t e = hipLaunchCooperativeKernel((const void*)mega_fwd, dim3(grid), dim3(NTHREADS), args, LDS_BYTES, stream);
    if (e != hipSuccess) fprintf(stderr, "cooperative launch failed: %s (grid %d)\n", hipGetErrorString(e), grid);
}
```

```cpp
#include <hip/hip_runtime.h>
#include <hip/hip_cooperative_groups.h>
#include <cstdio>
#include <cstdint>
namespace cg = cooperative_groups;

#define LAS __attribute__((address_space(3)))
typedef unsigned short bf16_t;
typedef short bf16x8 __attribute__((ext_vector_type(8)));
typedef float f32x4 __attribute__((ext_vector_type(4)));
typedef float f32x2 __attribute__((ext_vector_type(2)));
typedef float f32x16 __attribute__((ext_vector_type(16)));
typedef unsigned u32x4 __attribute__((ext_vector_type(4)));
typedef unsigned u32x2 __attribute__((ext_vector_type(2)));
struct __attribute__((packed, aligned(4))) U4A4 { unsigned x, y, z, w; };

constexpr int MP = 65536, MS = 16384, MT = 81920, DM = 1024, FF = 2816, DIN = 2048;
constexpr int LP = 8192, LS = 2048;
constexpr int NCHUNK = MT / 16;
constexpr float ALPHA = 1.189207115002721f;
constexpr float LN_EPS = 1e-5f, RMS_EPS = 1e-6f, FILTER_EPS = 1e-6f;
constexpr int NTHREADS = 512, NWAVES = 8;
constexpr int LDS_BYTES = 147456;

constexpr size_t MiB = 1u << 20;
constexpr size_t WS_WGU1 = 0 * MiB, WS_WD1 = 12 * MiB, WS_WIN = 18 * MiB, WS_WGLU = 22 * MiB, WS_WOUT = 23 * MiB, WS_WGU2 = 25 * MiB, WS_WD2 = 36 * MiB;
constexpr size_t WS_WEND = 42 * MiB, WS_WMAT = 46 * MiB, WS_SCAN = 54 * MiB, WS_PART = 55 * MiB  ;
constexpr size_t WS_XB = 58 * MiB;
constexpr size_t WS_H = 218 * MiB;
constexpr size_t WS_YHY = 658 * MiB;
constexpr size_t WS_FRAW = 738 * MiB;
constexpr size_t WS_FP = 802 * MiB;
constexpr size_t WS_FS = 868 * MiB;
constexpr size_t WS_STATS = 886 * MiB;
constexpr size_t WS_END = 888 * MiB;

__device__ __forceinline__ unsigned f2bf(float f) { unsigned u = __builtin_bit_cast(unsigned, f); return (u + 0x7fffu + ((u >> 16) & 1u)) >> 16; }
__device__ __forceinline__ unsigned pk2(float lo, float hi) { unsigned r; asm("v_cvt_pk_bf16_f32 %0, %1, %2" : "=v"(r) : "v"(lo), "v"(hi)); return r; }
__device__ __forceinline__ float bf_lo(unsigned u) { return __builtin_bit_cast(float, u << 16); }
__device__ __forceinline__ float bf_hi(unsigned u) { return __builtin_bit_cast(float, u & 0xffff0000u); }
__device__ __forceinline__ float bf2f(bf16_t h) { return __builtin_bit_cast(float, (unsigned)h << 16); }
__device__ __forceinline__ float wave_sum(float v) {
#pragma unroll
    for (int o = 1; o < 64; o <<= 1) v += __shfl_xor(v, o);
    return v;
}
#define LDS_WAIT() asm volatile("s_waitcnt lgkmcnt(0)" ::: "memory")

namespace pg8 {
constexpr int BM = 256, BK = 64, HALF = 128, HTB = HALF * BK * 2, NXCD = 8, WGM = 8;
__device__ __forceinline__ int lds_byte(int r, int c) { const int st = (r >> 4) * 2 + (c >> 5), rr = r & 15, cc = c & 31, ob = rr * 64 + cc * 2; return st * 1024 + (ob ^ (((ob >> 9) & 1) << 5)); }
__device__ __forceinline__ void stage_rc(int b, int& R, int& C) { const int st = b / 1024, sb = b % 1024, swz = sb ^ (((sb >> 9) & 1) << 5); R = (st >> 1) * 16 + swz / 64; C = (st & 1) * 32 + (swz % 64) / 2; }
__device__ __forceinline__ int perm32(int rho) { const int n = rho >> 4, i = rho & 15; return 8 * (i >> 2) + 4 * n + (i & 3); }
struct Unit { int pm, pn; };
struct Gemm { const bf16_t* A; const bf16_t* Bt; int K, lda, ldb; };
struct StaticOrder {
    int nM, nN, nwg, G, c;
    __device__ void init(int M, int N, int G_, int c_) { nM = M / BM; nN = N / BM; nwg = nM * nN; G = G_; c = c_; }
    __device__ bool next(int i, Unit& u) const {
        const long L = (long)i * G + c; if (L >= nwg) return false;
        int wgid = (int)L; { const int q = nwg / NXCD, r = nwg % NXCD, xcd = wgid % NXCD, off = wgid / NXCD; wgid = (xcd < r ? xcd * (q + 1) : r * (q + 1) + (xcd - r) * q) + off; }
        const int nig = WGM * nN, gid = wgid / nig, fm = gid * WGM, gsz = (nM - fm) < WGM ? (nM - fm) : WGM;
        u.pm = fm + ((wgid % nig) % gsz); u.pn = (wgid % nig) / gsz; return true;
    }
};
struct GroupOrder {
    int G, c;
    __device__ bool next(int i, Unit& u) const { const int L = i * G + c; if (L >= 640) return false; u.pm = L; u.pn = L / 20; return true; }
};

template <class Epi, class Sched, bool ALIGN_EPI>
__device__ __forceinline__ void gemm_phase(LAS unsigned char* lds, const Gemm g, const Sched& S, const Epi& E) {
    int tid_ = threadIdx.x; asm volatile("" : "+v"(tid_));
    const int tid = tid_, wid = __builtin_amdgcn_readfirstlane(tid >> 6), lane = tid & 63, wr = wid >> 2, wc = wid & 3, fr = lane & 15, fq = lane >> 4;
    const int K = g.K, nt = K / BK;
    unsigned voffA[2], voffB[2];
#pragma unroll
    for (int i = 0; i < 2; ++i) { int R, C; stage_rc(tid * 16 + i * 8192, R, C); const int Rb = (R & ~31) + perm32(R & 31);
        voffA[i] = (unsigned)(R * g.lda + C) * 2u; voffB[i] = (unsigned)(Rb * g.ldb + C) * 2u; }
    const size_t kstep = (size_t)(BK * 2);
    const size_t hstepA = (size_t)HALF * g.lda * 2, hstepB = (size_t)HALF * g.ldb * 2;
    const size_t tstepA = 2 * hstepA, tstepB = 2 * hstepB;
    const unsigned ldsw = (unsigned)wid * 1024u;
    const int aoff = lds_byte(wr * 64 + fr, fq * 8), boff = lds_byte(wc * 32 + fr, fq * 8);
#define PG8_SA(b, h) (((b) * 2 + (h)) * HTB)
#define PG8_SB(b, h) ((4 + (b) * 2 + (h)) * HTB)
#define PG8_STAGE(bufoff, gbase, voff) do { _Pragma("unroll") for (int _i = 0; _i < 2; ++_i) \
        __builtin_amdgcn_global_load_lds((const unsigned*)((const char*)(gbase) + (voff)[_i]), (LAS unsigned*)(lds + (bufoff) + ldsw + _i * 8192), 16, 0, 0); } while (0)
#define PG8_LDA(dst, b, h) do { _Pragma("unroll") for (int m = 0; m < 4; ++m) _Pragma("unroll") for (int k = 0; k < 2; ++k) dst[m][k] = *(const LAS bf16x8*)(lds + PG8_SA(b, h) + aoff + m * 2048 + k * 1024); } while (0)
#define PG8_LDB(dst, b, h) do { _Pragma("unroll") for (int n = 0; n < 2; ++n) _Pragma("unroll") for (int k = 0; k < 2; ++k) dst[n][k] = *(const LAS bf16x8*)(lds + PG8_SB(b, h) + boff + n * 2048 + k * 1024); } while (0)
#define PG8_MMA(ai, bj, At, Bt) do { __builtin_amdgcn_s_setprio(1); _Pragma("unroll") for (int m = 0; m < 4; ++m) _Pragma("unroll") for (int n = 0; n < 2; ++n) _Pragma("unroll") for (int k = 0; k < 2; ++k) \
        acc[ai][bj][m][n] = __builtin_amdgcn_mfma_f32_16x16x32_bf16(Bt[n][k], At[m][k], acc[ai][bj][m][n], 0, 0, 0); __builtin_amdgcn_s_setprio(0); } while (0)
#define PG8_WAIT_V(n) asm volatile("s_waitcnt vmcnt(" #n ")" ::: "memory")
#define PG8_WAIT_L(n) asm volatile("s_waitcnt lgkmcnt(" #n ")" ::: "memory")
#define PG8_BAR __builtin_amdgcn_s_barrier()
#define PG8_SCHED __builtin_amdgcn_sched_barrier(0)
    Unit cur, nxt; int ui = 0;
    if (!S.next(0, cur)) return;
    f32x4 acc[2][2][4][2];
#pragma unroll
    for (int a = 0; a < 2; ++a)
#pragma unroll
        for (int b = 0; b < 2; ++b)
#pragma unroll
            for (int m = 0; m < 4; ++m)
#pragma unroll
                for (int n = 0; n < 2; ++n) acc[a][b][m][n] = (f32x4){0.f, 0.f, 0.f, 0.f};
    bf16x8 At[4][2], B0[2][2], B1[2][2];
    const char* cA = (const char*)g.A + (size_t)cur.pm * tstepA; const char* cB = (const char*)g.Bt + (size_t)cur.pn * tstepB;
    PG8_STAGE(PG8_SB(0, 0), cB, voffB); PG8_STAGE(PG8_SB(0, 1), cB + hstepB, voffB); PG8_STAGE(PG8_SA(0, 0), cA, voffA); PG8_STAGE(PG8_SA(0, 1), cA + hstepA, voffA);
    if (wr == 1) PG8_BAR;
    PG8_WAIT_V(2); PG8_BAR;
    PG8_STAGE(PG8_SB(1, 0), cB + kstep, voffB); PG8_STAGE(PG8_SA(1, 0), cA + kstep, voffA); PG8_STAGE(PG8_SB(1, 1), cB + hstepB + kstep, voffB);
    PG8_WAIT_V(6); PG8_BAR;
    for (;;) {
        const bool has_next = S.next(ui + 1, nxt);
        const char* nA = has_next ? (const char*)g.A + (size_t)nxt.pm * tstepA : cA; const char* nB = has_next ? (const char*)g.Bt + (size_t)nxt.pn * tstepB : cB;
        for (int t = 0; t < nt; t += 2) {
            const bool last = (t == nt - 2);
            const char* a1 = cA + (size_t)(t + 1) * kstep;
            const char* a2 = last ? nA : cA + (size_t)(t + 2) * kstep; const char* b2 = last ? nB : cB + (size_t)(t + 2) * kstep;
            const char* a3 = a2 + kstep; const char* b3 = b2 + kstep;
            PG8_LDB(B0, 0, 0); PG8_LDB(B1, 0, 1); PG8_SCHED; PG8_LDA(At, 0, 0); PG8_STAGE(PG8_SA(1, 1), a1 + hstepA, voffA);
            PG8_WAIT_V(8); PG8_WAIT_L(0); PG8_BAR; PG8_MMA(0, 0, At, B0); PG8_MMA(0, 1, At, B1); PG8_BAR; PG8_SCHED;
            PG8_LDA(At, 0, 1); PG8_STAGE(PG8_SB(0, 0), b2, voffB); PG8_STAGE(PG8_SB(0, 1), b2 + hstepB, voffB); PG8_STAGE(PG8_SA(0, 0), a2, voffA);
            PG8_WAIT_V(8); PG8_WAIT_L(0); PG8_BAR; PG8_MMA(1, 0, At, B0); PG8_MMA(1, 1, At, B1); PG8_BAR; PG8_SCHED;
            PG8_LDB(B0, 1, 0); PG8_LDB(B1, 1, 1); PG8_SCHED; PG8_LDA(At, 1, 0); PG8_STAGE(PG8_SA(0, 1), a2 + hstepA, voffA);
            PG8_WAIT_V(8); PG8_WAIT_L(0); PG8_BAR; PG8_MMA(0, 0, At, B0); PG8_MMA(0, 1, At, B1); PG8_BAR; PG8_SCHED;
            PG8_LDA(At, 1, 1); PG8_STAGE(PG8_SB(1, 0), b3, voffB); PG8_STAGE(PG8_SB(1, 1), b3 + hstepB, voffB); PG8_STAGE(PG8_SA(1, 0), a3, voffA);
            PG8_WAIT_V(8); PG8_WAIT_L(0); PG8_BAR; PG8_MMA(1, 0, At, B0); PG8_MMA(1, 1, At, B1); PG8_BAR; PG8_SCHED;
        }
        if constexpr (ALIGN_EPI) { if (wr == 0) PG8_BAR; }
        { int l2 = threadIdx.x; asm volatile("" : "+v"(l2)); E(acc, cur, wr, wc, l2 & 15, (l2 >> 4) & 3); }
        if (!has_next) break;
#pragma unroll
        for (int a = 0; a < 2; ++a)
#pragma unroll
            for (int b = 0; b < 2; ++b)
#pragma unroll
                for (int m = 0; m < 4; ++m)
#pragma unroll
                    for (int n = 0; n < 2; ++n) acc[a][b][m][n] = (f32x4){0.f, 0.f, 0.f, 0.f};
        cur = nxt; cA = nA; cB = nB; ++ui;
        if constexpr (ALIGN_EPI) { if (wr == 1) PG8_BAR; }
    }
    PG8_WAIT_V(0);
    if constexpr (!ALIGN_EPI) { if (wr == 0) PG8_BAR; }
    PG8_BAR;
#undef PG8_SA
#undef PG8_SB
#undef PG8_STAGE
#undef PG8_LDA
#undef PG8_LDB
#undef PG8_MMA
#undef PG8_WAIT_V
#undef PG8_WAIT_L
#undef PG8_BAR
#undef PG8_SCHED
}

typedef f32x4 Acc[2][2][4][2];
__device__ __forceinline__ float sigmoidf(float x) { return __builtin_amdgcn_rcpf(1.f + __builtin_amdgcn_exp2f(-1.4426950408889634f * x)); }
__device__ __forceinline__ float gelu_tanh(float x) { const float z = 0.7978845608028654f * (x + 0.044715f * x * x * x); return x * sigmoidf(2.f * z); }
__device__ __forceinline__ u32x4 pack8(const f32x4 a, const f32x4 b) { u32x4 w; w.x = pk2(a[0], a[1]); w.y = pk2(a[2], a[3]); w.z = pk2(b[0], b[1]); w.w = pk2(b[2], b[3]); return w; }

template <class T> __device__ __forceinline__ T* gp(const void* base, unsigned byteoff) { return (T*)((char*)base + byteoff); }
struct EpiSwiGLU {
    bf16_t* H;
    __device__ __forceinline__ void operator()(const Acc& acc, const Unit& u, int wr, int wc, int fr, int fq) const {
        const int row0 = u.pm * BM + wr * 64 + fr, hid = u.pn * 128 + wc * 32 + 8 * fq;
        const unsigned off0 = (unsigned)(row0 * FF + hid) * 2u;
#pragma unroll
        for (int ai = 0; ai < 2; ++ai)
#pragma unroll
            for (int m = 0; m < 4; ++m) {
                f32x4 o[2];
#pragma unroll
                for (int n = 0; n < 2; ++n)
#pragma unroll
                    for (int j = 0; j < 4; ++j) { const float gt = acc[ai][0][m][n][j], up = acc[ai][1][m][n][j]; o[n][j] = gt * sigmoidf(gt) * up; }
                *gp<u32x4>(H, off0 + (unsigned)((ai * HALF + m * 16) * FF) * 2u) = pack8(o[0], o[1]);
            }
    }
};
struct EpiResid {
    const float* x0; const float* x1; float* out; float s;
    __device__ __forceinline__ void operator()(const Acc& acc, const Unit& u, int wr, int wc, int fr, int fq) const {
        const int row0 = u.pm * BM + wr * 64 + fr, col0 = u.pn * BM + wc * 32 + 8 * fq;
        const bool lo = u.pm * BM < MP;
        const float* xb = lo ? x0 : x1;
        const unsigned xoff0 = (unsigned)((lo ? row0 : row0 - MP) * DM + col0) * 4u, ooff0 = (unsigned)(row0 * DM + col0) * 4u;
#pragma unroll
        for (int ai = 0; ai < 2; ++ai)
#pragma unroll
            for (int m = 0; m < 4; ++m) {
                const unsigned d = (unsigned)((ai * HALF + m * 16) * DM) * 4u;
#pragma unroll
                for (int bj = 0; bj < 2; ++bj) {
                    const f32x4 a = *gp<const f32x4>(xb, xoff0 + d + bj * HALF * 4), b = *gp<const f32x4>(xb, xoff0 + d + bj * HALF * 4 + 16);
                    *gp<f32x4>(out, ooff0 + d + bj * HALF * 4) = a * ALPHA + acc[ai][bj][m][0] * s;
                    *gp<f32x4>(out, ooff0 + d + bj * HALF * 4 + 16) = b * ALPHA + acc[ai][bj][m][1] * s;
                }
            }
    }
};
struct EpiResidLN {
    float* out; const f32x2* stats; const float* gam; const float* bet; float s;
    __device__ __forceinline__ void operator()(const Acc& acc, const Unit& u, int wr, int wc, int fr, int fq) const {
        const int row0 = u.pm * BM + wr * 64 + fr, col0 = u.pn * BM + wc * 32 + 8 * fq;
        const unsigned ooff0 = (unsigned)(row0 * DM + col0) * 4u;
        f32x4 gv[2][2], bv[2][2];
#pragma unroll
        for (int bj = 0; bj < 2; ++bj)
#pragma unroll
            for (int n = 0; n < 2; ++n) { gv[bj][n] = *(const f32x4*)(gam + col0 + bj * HALF + 4 * n) * ALPHA; bv[bj][n] = *(const f32x4*)(bet + col0 + bj * HALF + 4 * n) * ALPHA; }
#pragma unroll
        for (int ai = 0; ai < 2; ++ai)
#pragma unroll
            for (int m = 0; m < 4; ++m) {
                const unsigned d = (unsigned)((ai * HALF + m * 16) * DM) * 4u;
                const f32x2 st = *gp<const f32x2>(stats, (unsigned)(row0 + ai * HALF + m * 16) * 8u);
#pragma unroll
                for (int bj = 0; bj < 2; ++bj) {
                    const f32x4 a = *gp<const f32x4>(out, ooff0 + d + bj * HALF * 4), b = *gp<const f32x4>(out, ooff0 + d + bj * HALF * 4 + 16);
                    *gp<f32x4>(out, ooff0 + d + bj * HALF * 4) = (a - st[0]) * st[1] * gv[bj][0] + bv[bj][0] + acc[ai][bj][m][0] * s;
                    *gp<f32x4>(out, ooff0 + d + bj * HALF * 4 + 16) = (b - st[0]) * st[1] * gv[bj][1] + bv[bj][1] + acc[ai][bj][m][1] * s;
                }
            }
    }
};
struct EpiWin {
    bf16_t* UEXT; bf16_t* PHY;
    __device__ __forceinline__ void operator()(const Acc& acc, const Unit& u, int wr, int wc, int fr, int fq) const {
        const int row0 = u.pm * BM + wr * 64 + fr, col0 = u.pn * BM + wc * 32 + 8 * fq;
        if (u.pn < 2) {
#pragma unroll
            for (int ai = 0; ai < 2; ++ai)
#pragma unroll
                for (int m = 0; m < 4; ++m) {
                    const int row = row0 + ai * HALF + m * 16, chunk = row >> 4, tl = row & 15;
#pragma unroll
                    for (int bj = 0; bj < 2; ++bj) { const int c0 = col0 + bj * HALF, g = c0 >> 4, h0 = c0 & 15;
                        *gp<u32x4>(UEXT, (unsigned)((g * NCHUNK + chunk) * 512 + tl * 16 + h0) * 2u) = pack8(acc[ai][bj][m][0], acc[ai][bj][m][1]); }
                }
        } else {
            const unsigned off0 = (unsigned)((col0 - 512) * MT + row0) * 2u;
#pragma unroll
            for (int bj = 0; bj < 2; ++bj)
#pragma unroll
                for (int n = 0; n < 2; ++n)
#pragma unroll
                    for (int j = 0; j < 4; ++j) {
                        const unsigned co = off0 + (unsigned)((bj * HALF + 4 * n + j) * MT) * 2u;
#pragma unroll
                        for (int ai = 0; ai < 2; ++ai)
#pragma unroll
                            for (int m = 0; m < 4; m += 2) { const unsigned pr = pk2(acc[ai][bj][m][n][j], acc[ai][bj][m + 1][n][j]);
                                *gp<bf16_t>(PHY, co + (unsigned)(ai * HALF + m * 16) * 2u) = (bf16_t)(pr & 0xffffu); *gp<bf16_t>(PHY, co + (unsigned)(ai * HALF + m * 16 + 16) * 2u) = (bf16_t)(pr >> 16); }
                    }
        }
    }
};
struct EpiS {
    float* S;
    __device__ __forceinline__ void operator()(const Acc& acc, const Unit& u, int wr, int wc, int fr, int fq) const {
        const int row0 = u.pm * BM + wr * 64 + fr, col0 = wc * 32 + 8 * fq;
        const unsigned off0 = (unsigned)(row0 * 256 + col0) * 4u;
#pragma unroll
        for (int ai = 0; ai < 2; ++ai)
#pragma unroll
            for (int m = 0; m < 4; ++m) { const unsigned d = off0 + (unsigned)((ai * HALF + m * 16) * 256) * 4u;
#pragma unroll
                for (int bj = 0; bj < 2; ++bj) { *gp<f32x4>(S, d + bj * HALF * 4) = acc[ai][bj][m][0]; *gp<f32x4>(S, d + bj * HALF * 4 + 16) = acc[ai][bj][m][1]; } }
    }
};
struct EpiY {
    bf16_t* G;
    __device__ __forceinline__ void operator()(const Acc& acc, const Unit& u, int wr, int wc, int fr, int fq) const {
        const int g = u.pn, row0 = u.pm * BM + wr * 64 + fr - g * NCHUNK, col0 = wc * 32 + 8 * fq;
#pragma unroll
        for (int ai = 0; ai < 2; ++ai)
#pragma unroll
            for (int m = 0; m < 4; ++m) { const int chunk = row0 + ai * HALF + m * 16;
#pragma unroll
                for (int bj = 0; bj < 2; ++bj) { const int col = col0 + bj * HALF, t = col >> 4, h0 = col & 15;
                    f32x4 o[2];
#pragma unroll
                    for (int n = 0; n < 2; ++n)
#pragma unroll
                        for (int j = 0; j < 4; ++j) o[n][j] = gelu_tanh(acc[ai][bj][m][n][j]);
                    *gp<u32x4>(G, (unsigned)((chunk * 16 + t) * 512 + g * 16 + h0) * 2u) = pack8(o[0], o[1]); } }
    }
};
struct EpiGLU {
    const bf16_t* G; const float* bias; bf16_t* Y;
    __device__ __forceinline__ void operator()(const Acc& acc, const Unit& u, int wr, int wc, int fr, int fq) const {
        const int row0 = u.pm * BM + wr * 64 + fr, col0 = u.pn * BM + wc * 32 + 8 * fq;
#pragma unroll
        for (int bj = 0; bj < 2; ++bj) { const int col = col0 + bj * HALF;
            const f32x4 b0 = *(const f32x4*)(bias + col), b1 = *(const f32x4*)(bias + col + 4);
#pragma unroll
            for (int ai = 0; ai < 2; ++ai)
#pragma unroll
                for (int m = 0; m < 4; ++m) { const unsigned off = (unsigned)((row0 + ai * HALF + m * 16) * 512 + col) * 2u;
                    const u32x4 gv = *gp<const u32x4>(G, off);
                    const float gg[8] = {bf_lo(gv.x), bf_hi(gv.x), bf_lo(gv.y), bf_hi(gv.y), bf_lo(gv.z), bf_hi(gv.z), bf_lo(gv.w), bf_hi(gv.w)};
                    f32x4 o[2];
#pragma unroll
                    for (int j = 0; j < 4; ++j) { o[0][j] = gg[j] * sigmoidf(acc[ai][bj][m][0][j] + b0[j]); o[1][j] = gg[4 + j] * sigmoidf(acc[ai][bj][m][1][j] + b1[j]); }
                    *gp<u32x4>(Y, off) = pack8(o[0], o[1]); } }
    }
};
}
using pg8::gp;

struct Params { const float* in[38]; float* out; unsigned char* ws; };
enum { I_XP = 0, I_XS, I_G1, I_U1, I_D1, I_LN1G, I_LN1B, I_WIN, I_LRE, I_LIM, I_LSTEP, I_BRE, I_BIM, I_CRE, I_CIM, I_SD, I_GLUW, I_GLUB, I_SNG,
       I_HSW, I_HSB, I_FW1, I_FB1, I_FW2, I_FB2, I_FW3, I_SFREQ, I_LDEC, I_HBIAS, I_HNG, I_WOUT, I_LN2G, I_LN2B, I_G2, I_U2, I_D2, I_LN3G, I_LN3B };

__device__ __forceinline__ void transpose_item(const float* W, int K, int N, bf16_t* WT, int k0, int n0, int dst_row0, LAS float* scr, int lane) {
#pragma unroll 8
    for (int i = 0; i < 32; ++i) { const int kk = 2 * i + (lane >> 5); scr[kk * 33 + (lane & 31)] = W[(size_t)(k0 + kk) * N + n0 + (lane & 31)]; }
    LDS_WAIT();
    const int c = lane & 7;
#pragma unroll
    for (int j = 0; j < 4; ++j) { const int n = (lane >> 3) + 8 * j; const LAS float* s = scr + (8 * c) * 33 + n;
        u32x4 o; o.x = pk2(s[0 * 33], s[1 * 33]); o.y = pk2(s[2 * 33], s[3 * 33]); o.z = pk2(s[4 * 33], s[5 * 33]); o.w = pk2(s[6 * 33], s[7 * 33]);
        *(u32x4*)(WT + (size_t)(dst_row0 + n) * K + k0 + 8 * c) = o; }
    LDS_WAIT();
}

__device__ __forceinline__ void transpose_job(const Params& P, int it, LAS float* scr, int lane) {
    unsigned char* ws = P.ws;
    const float* W; bf16_t* WT; int K, N, mode = 0;
    constexpr int I_GU = 16 * 88, I_D = 44 * 32, I_IN = 16 * 64, I_GL = 8 * 16, I_O = 16 * 32;
    int r = it;
    if (r < I_GU) { W = P.in[I_G1]; WT = (bf16_t*)(ws + WS_WGU1); K = DM; N = FF; mode = 1; }
    else if ((r -= I_GU) < I_GU) { W = P.in[I_U1]; WT = (bf16_t*)(ws + WS_WGU1); K = DM; N = FF; mode = 2; }
    else if ((r -= I_GU) < I_D) { W = P.in[I_D1]; WT = (bf16_t*)(ws + WS_WD1); K = FF; N = DM; }
    else if ((r -= I_D) < I_IN) { W = P.in[I_WIN]; WT = (bf16_t*)(ws + WS_WIN); K = DM; N = DIN; }
    else if ((r -= I_IN) < I_GL) { W = P.in[I_GLUW]; WT = (bf16_t*)(ws + WS_WGLU); K = 512; N = 512; }
    else if ((r -= I_GL) < I_O) { W = P.in[I_WOUT]; WT = (bf16_t*)(ws + WS_WOUT); K = DM; N = DM; }
    else if ((r -= I_O) < I_GU) { W = P.in[I_G2]; WT = (bf16_t*)(ws + WS_WGU2); K = DM; N = FF; mode = 1; }
    else if ((r -= I_GU) < I_GU) { W = P.in[I_U2]; WT = (bf16_t*)(ws + WS_WGU2); K = DM; N = FF; mode = 2; }
    else { r -= I_GU; W = P.in[I_D2]; WT = (bf16_t*)(ws + WS_WD2); K = FF; N = DM; }
    const int nblk = N / 32, kb = r / nblk, nb = r % nblk, k0 = 64 * kb, n0 = 32 * nb;
    const int dst = mode ? (256 * (n0 >> 7) + (n0 & 127) + (mode == 2 ? 128 : 0)) : n0;
    transpose_item(W, K, N, WT, k0, n0, dst, scr, lane);
}
constexpr int N_TRANSPOSE_ITEMS = 6 * 1408 + 1024 + 128 + 512;

__device__ __forceinline__ void filt_raw_item(LAS float* sm, const Params& P, int item, int tid) {
    LAS float* feats = sm;
    LAS float* h1 = sm + 640;
    LAS float* h2 = sm + 640 + 2048;
    const int t0 = item * 32;
    for (int fi = tid; fi < 32 * 17; fi += NTHREADS) { const int tt = fi / 17, f = fi % 17; const int t = t0 + tt; float v;
        if (f == 0) v = (float)t * (1.0f / 4096.0f);
        else { const int k = (f - 1) & 7; const float om = ((k & 1) ? 0.31622776601683794f : 1.0f) * ((k >> 1) == 0 ? 1.0f : (k >> 1) == 1 ? 0.1f : (k >> 1) == 2 ? 0.01f : 0.001f);
            const float p = (float)t * om, e = fmaf((float)t, om, -p); const float kk = rintf(p * 0.15915494309189535f);
            float r = fmaf(-kk, 6.28125f, p); r = fmaf(-kk, 1.9353071795864769e-3f, r) + e; v = (f <= 8) ? sinf(r) : cosf(r); }
        feats[tt * 20 + f] = v; }
    __syncthreads();
    const float* w1 = P.in[I_FW1]; const float* b1 = P.in[I_FB1]; const float* w2 = P.in[I_FW2]; const float* b2 = P.in[I_FB2]; const float* sf = P.in[I_SFREQ];
    for (int idx = tid; idx < 2048; idx += NTHREADS) { const int tt = idx >> 6, k = idx & 63; float s = b1[k];
#pragma unroll
        for (int f = 0; f < 17; ++f) s += feats[tt * 20 + f] * w1[f * 64 + k];
        h1[idx] = sinf(sf[k] * s); }
    __syncthreads();
    for (int idx = tid; idx < 2048; idx += NTHREADS) { const int tt = idx >> 6, k = idx & 63; float s = b2[k];
        for (int f = 0; f < 64; ++f) s += h1[tt * 64 + f] * w2[f * 64 + k];
        h2[idx] = sinf(sf[64 + k] * s); }
    __syncthreads();
    const int n = tid * 4; const float* w3 = P.in[I_FW3];
    const f32x4 ld = *(const f32x4*)(P.in[I_LDEC] + n);
    f32x4 rate; rate[0] = expf(ld[0]); rate[1] = expf(ld[1]); rate[2] = expf(ld[2]); rate[3] = expf(ld[3]);
    const bool bwd = ((n >> 9) & 1) != 0;
    float* FRAW = (float*)(P.ws + WS_FRAW);
    f32x4 asum = (f32x4){0.f, 0.f, 0.f, 0.f};
#pragma unroll 1
    for (int hf = 0; hf < 2; ++hf) {
        f32x4 acc[16];
#pragma unroll
        for (int tt = 0; tt < 16; ++tt) acc[tt] = (f32x4){0.f, 0.f, 0.f, 0.f};
#pragma unroll 1
        for (int k = 0; k < 64; k += 4) {
            const f32x4 wa = *(const f32x4*)(w3 + (size_t)(k + 0) * 2048 + n), wb = *(const f32x4*)(w3 + (size_t)(k + 1) * 2048 + n),
                        wc = *(const f32x4*)(w3 + (size_t)(k + 2) * 2048 + n), wd = *(const f32x4*)(w3 + (size_t)(k + 3) * 2048 + n);
#pragma unroll
            for (int tt = 0; tt < 16; ++tt) { const f32x4 hv = *(const LAS f32x4*)(h2 + (hf * 16 + tt) * 64 + k); acc[tt] += wa * hv[0] + wb * hv[1] + wc * hv[2] + wd * hv[3]; }
        }
#pragma unroll
        for (int tt = 0; tt < 16; ++tt) { const int t = t0 + hf * 16 + tt; const float tl = (float)t * (1.0f / 4096.0f);
            f32x4 v; v[0] = acc[tt][0] * expf(-tl * rate[0]); v[1] = acc[tt][1] * expf(-tl * rate[1]); v[2] = acc[tt][2] * expf(-tl * rate[2]); v[3] = acc[tt][3] * expf(-tl * rate[3]);
            *(f32x4*)(FRAW + (size_t)t * 2048 + n) = v;
            if (!(bwd && t == 0)) { asum[0] += fabsf(v[0]); asum[1] += fabsf(v[1]); asum[2] += fabsf(v[2]); asum[3] += fabsf(v[3]); } }
    }
    *(f32x4*)((float*)(P.ws + WS_PART) + (size_t)item * 2048 + n) = asum;
    __syncthreads();
}

__device__ __forceinline__ void s5_mats(LAS float* sm, const Params& P, int g, int tid) {
    LAS float* POWr = sm;
    LAS float* POWi = sm + 2176;
    LAS float* BBr = sm + 4352;
    LAS float* BBi = BBr + 2048;
    LAS float* Cr = BBi + 2048;
    LAS float* Ci = Cr + 2048;
    LAS float* Kt = Ci + 2048;
    const float* lre = P.in[I_LRE]; const float* lim = P.in[I_LIM]; const float* lst = P.in[I_LSTEP];
    for (int idx = tid; idx < 2176; idx += NTHREADS) { const int dir = idx / 1088, rem = idx % 1088, n = rem >> 6, p = rem & 63;
        const float step = expf(lst[dir * 32 + g]); const float lr = lre[(dir * 32 + g) * 64 + p], li = lim[(dir * 32 + g) * 64 + p];
        const float mag = expf(lr * step * (float)n), ang = li * step * (float)n;
        POWr[idx] = mag * cosf(ang); POWi[idx] = mag * sinf(ang); }
    for (int idx = tid; idx < 2048; idx += NTHREADS) { const int dir = idx >> 10, h = (idx >> 6) & 15, p = idx & 63;
        Cr[idx] = P.in[I_CRE][((size_t)(dir * 32 + g) * 16 + h) * 64 + p]; Ci[idx] = P.in[I_CIM][((size_t)(dir * 32 + g) * 16 + h) * 64 + p]; }
    __syncthreads();
    for (int idx = tid; idx < 2048; idx += NTHREADS) { const int dir = idx >> 10, p = (idx >> 4) & 63, h = idx & 15;
        const float lr = lre[(dir * 32 + g) * 64 + p], li = lim[(dir * 32 + g) * 64 + p];
        const float ar = POWr[dir * 1088 + 64 + p], ai = POWi[dir * 1088 + 64 + p];
        const float nr = ar - 1.0f, ni = ai, den = lr * lr + li * li;
        const float qr = (nr * lr + ni * li) / den, qi = (ni * lr - nr * li) / den;
        const float br = P.in[I_BRE][((size_t)(dir * 32 + g) * 64 + p) * 16 + h], bi = P.in[I_BIM][((size_t)(dir * 32 + g) * 64 + p) * 16 + h];
        BBr[idx] = qr * br - qi * bi; BBi[idx] = qr * bi + qi * br; }
    __syncthreads();
    for (int idx = tid; idx < 8192; idx += NTHREADS) { const int dir = idx >> 12, n = (idx >> 8) & 15, h = (idx >> 4) & 15, h2 = idx & 15; float s = 0.f;
        for (int p = 0; p < 64; ++p) { const float cr = Cr[dir * 1024 + h * 64 + p], ci = Ci[dir * 1024 + h * 64 + p], pr = POWr[dir * 1088 + n * 64 + p], pi = POWi[dir * 1088 + n * 64 + p];
            const float tr = cr * pr - ci * pi, ti = cr * pi + ci * pr; s += tr * BBr[dir * 1024 + p * 16 + h2] - ti * BBi[dir * 1024 + p * 16 + h2]; }
        Kt[idx] = s; }
    __syncthreads();
    bf16_t* WMAT = (bf16_t*)(P.ws + WS_WMAT) + (size_t)g * 256 * 512;
    bf16_t* WEND = (bf16_t*)(P.ws + WS_WEND) + (size_t)g * 256 * 256;
    const float* sd = P.in[I_SD] + g * 16;
    for (int idx = tid; idx < 256 * 256; idx += NTHREADS) {
        const int row = idx >> 8, col = (idx & 255) * 2, t = row >> 4, h = row & 15; float v[2];
#pragma unroll
        for (int e = 0; e < 2; ++e) { const int cc = col + e;
            if (cc < 256) { const int s = cc >> 4, h2 = cc & 15; float x = 0.f;
                if (s <= t) x += Kt[((0 * 16 + (t - s)) * 16 + h) * 16 + h2];
                if (s >= t) x += Kt[((1 * 16 + (s - t)) * 16 + h) * 16 + h2];
                if (s == t && h == h2) x += sd[h];
                v[e] = x; }
            else { const int c2 = cc - 256, dir = c2 >> 7, p = (c2 >> 1) & 63, ri = c2 & 1; const int ex = dir == 0 ? t + 1 : 16 - t;
                const float cr = Cr[dir * 1024 + h * 64 + p], ci = Ci[dir * 1024 + h * 64 + p], pr = POWr[dir * 1088 + ex * 64 + p], pi = POWi[dir * 1088 + ex * 64 + p];
                v[e] = ri == 0 ? (cr * pr - ci * pi) : -(cr * pi + ci * pr); } }
        *(unsigned*)(WMAT + (size_t)row * 512 + col) = pk2(v[0], v[1]); }
    for (int idx = tid; idx < 256 * 128; idx += NTHREADS) {
        const int row = idx >> 7, col = (idx & 127) * 2, dir = row >> 7, p = (row >> 1) & 63, ri = row & 1; float v[2];
#pragma unroll
        for (int e = 0; e < 2; ++e) { const int cc = col + e, s = cc >> 4, h2 = cc & 15; const int ex = dir == 0 ? 15 - s : s;
            const float pr = POWr[dir * 1088 + ex * 64 + p], pi = POWi[dir * 1088 + ex * 64 + p], br = BBr[dir * 1024 + p * 16 + h2], bi = BBi[dir * 1024 + p * 16 + h2];
            v[e] = ri == 0 ? (pr * br - pi * bi) : (pr * bi + pi * br); }
        *(unsigned*)(WEND + (size_t)row * 256 + col) = pk2(v[0], v[1]); }
    float* A16 = (float*)(P.ws + WS_SCAN);
    if (tid < 128) { const int dir = tid >> 6, p = tid & 63; A16[((g * 2 + dir) * 64 + p) * 2 + 0] = POWr[dir * 1088 + 16 * 64 + p]; A16[((g * 2 + dir) * 64 + p) * 2 + 1] = POWi[dir * 1088 + 16 * 64 + p]; }
    __syncthreads();
}

__device__ __forceinline__ void filt_norm_item(const Params& P, int it, LAS float* scr, int lane) {
    int ty, r = it;
    if (r < 1024) ty = 0; else { ty = 1; r -= 1024; }
    const int ntc = ty ? 4 : 16;
    const int tch = r % ntc; r /= ntc; const int ctile = r & 15; r >>= 4; const int dir = r & 1, o = r >> 1;
    const int L = ty ? LS : LP, RLEN = 2 * L + 64, C0 = L + 32, np = ty ? 64 : 256;
    const int cc = lane & 31, half = lane >> 5, c = ctile * 32 + cc, n = o * 1024 + dir * 512 + c;
    const float* PART = (const float*)(P.ws + WS_PART); const float* FRAW = (const float*)(P.ws + WS_FRAW);
    float s = 0.f;
    for (int i = 0; i < np; ++i) s += PART[(size_t)i * 2048 + o * 1024 + c] + PART[(size_t)i * 2048 + o * 1024 + 512 + c];
    const float inv = 1.0f / (s + FILTER_EPS);
    bf16_t* F = (bf16_t*)(P.ws + (ty ? WS_FS : WS_FP));
    for (int tt0 = tch * 512; tt0 < tch * 512 + 512; tt0 += 64) {
#pragma unroll 8
        for (int i = 0; i < 32; ++i) { const int tl = 2 * i + half; scr[tl * 33 + cc] = FRAW[(size_t)(tt0 + tl) * 2048 + n] * inv; }
        LDS_WAIT();
        const int t = tt0 + lane; const int idx = dir ? C0 + t : C0 - t; const bool wr = !(dir && t == 0);
        for (int c2 = 0; c2 < 32; ++c2) { const bf16_t v = (bf16_t)f2bf(scr[lane * 33 + c2]); bf16_t* dst = F + (size_t)(o * 512 + ctile * 32 + c2) * (2 * RLEN);
            if (wr) { dst[idx] = v; dst[RLEN + idx - 1] = v; } }
        LDS_WAIT();
    }
}
constexpr int N_FNORM_ITEMS = 1024 + 256;

template <bool FINAL>
__device__ __forceinline__ void ln_rows(float* X, bf16_t* XB, f32x2* stats, const float* gam, const float* bet, int gw, int ngw, int lane) {
    f32x4 gv[4], bv[4];
#pragma unroll
    for (int j = 0; j < 4; ++j) { gv[j] = *(const f32x4*)(gam + 4 * lane + 256 * j); bv[j] = *(const f32x4*)(bet + 4 * lane + 256 * j); }
    for (int m = gw; m < MT; m += ngw) {
        float* xr = X + (size_t)m * DM + 4 * lane; f32x4 v[4]; float s = 0.f;
#pragma unroll
        for (int j = 0; j < 4; ++j) { v[j] = *(const f32x4*)(xr + 256 * j); s += (v[j][0] + v[j][1]) + (v[j][2] + v[j][3]); }
        const float mean = wave_sum(s) * (1.f / DM); float s2 = 0.f;
#pragma unroll
        for (int j = 0; j < 4; ++j) { v[j] = v[j] - mean; s2 += (v[j][0] * v[j][0] + v[j][1] * v[j][1]) + (v[j][2] * v[j][2] + v[j][3] * v[j][3]); }
        const float rstd = 1.f / sqrtf(wave_sum(s2) * (1.f / DM) + LN_EPS);
        if (!FINAL && lane == 0) stats[m] = (f32x2){mean, rstd};
#pragma unroll
        for (int j = 0; j < 4; ++j) { const f32x4 o = v[j] * rstd * gv[j] + bv[j];
            if (FINAL) *(f32x4*)(xr + 256 * j) = o;
            else { u32x2 w; w.x = pk2(o[0], o[1]); w.y = pk2(o[2], o[3]); *(u32x2*)(XB + (size_t)m * DM + 4 * lane + 256 * j) = w; } }
    }
}

constexpr int ZERO_OFF = 131072;
#ifndef RING
#define RING 4
#endif
#ifndef HBSEL
#define HBSEL 2
#endif
__device__ __forceinline__ u32x4 ld_filt(const bf16_t* p) { const U4A4 v = *(const U4A4*)p; u32x4 w; w.x = v.x; w.y = v.y; w.z = v.z; w.w = v.w; return w; }

constexpr int ZB = 4096;
template <int NB>
__device__ __forceinline__ void hyena_unit(LAS unsigned char* lds, const Params& P, int c, int ty) {
    constexpr int L = NB * 32, NT = NB / 32, RLEN = 2 * L + 64, C0 = L + 32, BPW = NB / 8, ZBYTES = NB * 8 * 64;
    constexpr int HB = (NT >= 4 && HBSEL == 4) ? 4 : 2;
    int tid_ = threadIdx.x; asm volatile("" : "+v"(tid_));
    const int tid = tid_, wave = __builtin_amdgcn_readfirstlane(tid >> 6), lane = tid & 63, n = lane & 31, hh = lane >> 5;
    const int tb = ty ? MP : 0;
    const bf16_t* PHY = (const bf16_t*)(P.ws + WS_H + 160 * MiB);
    bf16_t* YHY = (bf16_t*)(P.ws + WS_YHY);
    const bf16_t* FILT = (const bf16_t*)(P.ws + (ty ? WS_FS : WS_FP));
    const float* sw = P.in[I_HSW]; const float* sb = P.in[I_HSB];
    LAS unsigned char* Z = lds + ZB;
    {
        const bf16_t* pv = PHY + (size_t)c * MT + tb;
        const float w0 = sw[c], w1 = sw[1536 + c], w2 = sw[3072 + c], bb = sb[c];
        if (tid < 224) *(LAS u32x4*)(lds + ZB - 3584 + tid * 16) = (u32x4){0u, 0u, 0u, 0u};
        else if (tid < 448) *(LAS u32x4*)(lds + ZB + ZBYTES + (tid - 224) * 16) = (u32x4){0u, 0u, 0u, 0u};
#pragma unroll 4
        for (int ci = tid; ci < L; ci += NTHREADS) {
            const int b = ci / (L / 8), t0 = (ci % (L / 8)) * 8;
            const bf16_t* p = pv + (size_t)b * L + t0;
            const u32x4 raw = *(const u32x4*)p;
            float x[10];
            x[0] = t0 > 0 ? bf2f(p[-1]) : 0.f; x[9] = (t0 + 8 < L) ? bf2f(p[8]) : 0.f;
            x[1] = bf_lo(raw.x); x[2] = bf_hi(raw.x); x[3] = bf_lo(raw.y); x[4] = bf_hi(raw.y); x[5] = bf_lo(raw.z); x[6] = bf_hi(raw.z); x[7] = bf_lo(raw.w); x[8] = bf_hi(raw.w);
            float v[8];
#pragma unroll
            for (int e = 0; e < 8; ++e) v[e] = bb + w0 * x[e] + w1 * x[e + 1] + w2 * x[e + 2];
            u32x4 o; o.x = pk2(v[0], v[1]); o.y = pk2(v[2], v[3]); o.z = pk2(v[4], v[5]); o.w = pk2(v[6], v[7]);
            const int row = (t0 >> 5) * 8 + b, chunk = (t0 & 31) >> 3;
            *(LAS u32x4*)(Z + row * 64 + ((chunk ^ ((row >> 2) & 3)) << 4)) = o;
        }
    }
    __syncthreads();
    const int i_lo = wave * BPW;
    const int swE = (n >> 2) & 3, swO = ((n >> 2) + 2) & 3;
    const int offE0 = n * 64 + ((hh ^ swE) << 4), offE1 = n * 64 + (((2 + hh) ^ swE) << 4);
    const int offO0 = n * 64 + ((hh ^ swO) << 4), offO1 = n * 64 + (((2 + hh) ^ swO) << 4);
#pragma unroll 1
    for (int o = 0; o < 2; ++o) {
        const bf16_t* R0 = FILT + (size_t)(o * 512 + c) * (2 * RLEN);
        const int rl = ((n & 1) * (RLEN - 1) + (C0 - n + 8 * hh)) * 2;
        f32x16 acc[NT];
#pragma unroll
        for (int T = 0; T < NT; ++T)
#pragma unroll
            for (int e = 0; e < 16; ++e) acc[T][e] = 0.f;
        const int d0 = i_lo - (NB - 1); constexpr int nd = NB + BPW - 1;
        u32x4 ring[4][2];
#pragma unroll
        for (int u = 0; u < 4; ++u) { ring[u][0] = ld_filt(gp<const bf16_t>(R0, (unsigned)(rl - 64 * (d0 + u)))); ring[u][1] = ld_filt(gp<const bf16_t>(R0, (unsigned)(rl - 64 * (d0 + u) + 32))); }
#define HY_A(u) const bf16x8 A0 = __builtin_bit_cast(bf16x8, ring[u][0]), A1 = __builtin_bit_cast(bf16x8, ring[u][1]);
#define HY_NEXT(u, dd) if ((dd) + 4 < nd) { ring[u][0] = ld_filt(gp<const bf16_t>(R0, (unsigned)(rl - 64 * (d0 + (dd) + 4)))); ring[u][1] = ld_filt(gp<const bf16_t>(R0, (unsigned)(rl - 64 * (d0 + (dd) + 4) + 32))); }
#define HY_BASES(jb_) const int base0 = (jb_) * 512 + (((jb_) & 1) ? offO0 : offE0), base1 = (jb_) * 512 + (((jb_) & 1) ? offO1 : offE1)
#define HY_EDGE(u, dd) if ((dd) < nd) { HY_A(u) const int jb = i_lo - (d0 + (dd)); HY_BASES(jb); \
        _Pragma("unroll") for (int bi = 0; bi < NT / HB; ++bi) { const int j0 = jb + 4 * HB * bi; if (j0 > -4 * HB && j0 < NB) { bf16x8 be[2 * HB]; \
            _Pragma("unroll") for (int q = 0; q < HB; ++q) { be[2 * q] = *(const LAS bf16x8*)(Z + base0 + (bi * HB + q) * 2048); be[2 * q + 1] = *(const LAS bf16x8*)(Z + base1 + (bi * HB + q) * 2048); } \
            _Pragma("unroll") for (int q = 0; q < HB; ++q) acc[bi * HB + q] = __builtin_amdgcn_mfma_f32_32x32x16_bf16(A0, be[2 * q], acc[bi * HB + q], 0, 0, 0); \
            _Pragma("unroll") for (int q = 0; q < HB; ++q) acc[bi * HB + q] = __builtin_amdgcn_mfma_f32_32x32x16_bf16(A1, be[2 * q + 1], acc[bi * HB + q], 0, 0, 0); } } \
        HY_NEXT(u, dd) }
#pragma unroll 1
        for (int dg = 0; dg < BPW; dg += 4) {
#pragma unroll
            for (int u = 0; u < 4; ++u) HY_EDGE(u, dg + u)
        }
        {
            constexpr int NBATCH = NT / HB;
            bf16x8 Bq[2][2 * HB];
#define HY_READ(buf, bi) _Pragma("unroll") for (int q = 0; q < HB; ++q) { Bq[buf][2 * q] = *(const LAS bf16x8*)(Z + base0 + ((bi) * HB + q) * 2048); Bq[buf][2 * q + 1] = *(const LAS bf16x8*)(Z + base1 + ((bi) * HB + q) * 2048); }
            { HY_BASES(i_lo - (d0 + BPW)); HY_READ(0, 0) }
#pragma unroll 1
            for (int dg = BPW; dg < NB; dg += 4) {
#pragma unroll
                for (int u = 0; u < 4; ++u) {
                    const int dd = dg + u;
                    HY_A(u)
                    const int jb = i_lo - (d0 + dd);
                    constexpr int pb = (NBATCH & 1) ? 1 : 0;
#pragma unroll
                    for (int bi = 0; bi < NBATCH; ++bi) {
                        const int cur = (bi + pb * u) & 1;
                        if (bi + 1 < NBATCH) { HY_BASES(jb); HY_READ(cur ^ 1, bi + 1) }
                        else if (dd + 1 < NB) { HY_BASES(jb - 1); HY_READ(cur ^ 1, 0) }
                        __builtin_amdgcn_sched_barrier(0);
#pragma unroll
                        for (int q = 0; q < HB; ++q) acc[bi * HB + q] = __builtin_amdgcn_mfma_f32_32x32x16_bf16(A0, Bq[cur][2 * q], acc[bi * HB + q], 0, 0, 0);
#pragma unroll
                        for (int q = 0; q < HB; ++q) acc[bi * HB + q] = __builtin_amdgcn_mfma_f32_32x32x16_bf16(A1, Bq[cur][2 * q + 1], acc[bi * HB + q], 0, 0, 0);
                        __builtin_amdgcn_sched_barrier(0);
                    }
                    HY_NEXT(u, dd)
                }
            }
#undef HY_READ
        }
#pragma unroll 1
        for (int dg = NB; dg < nd; dg += 4) {
#pragma unroll
            for (int u = 0; u < 4; ++u) HY_EDGE(u, dg + u)
        }
#undef HY_EDGE
#undef HY_BASES
#undef HY_NEXT
#undef HY_A
        __syncthreads();
        {
            int l3 = threadIdx.x; asm volatile("" : "+v"(l3));
            const int n3 = l3 & 31, h3 = (l3 >> 5) & 1;
            const int gch = 512 * (o + 1) + c;
            const bf16_t* pg = PHY + (size_t)gch * MT + tb;
            bf16_t* py = YHY + (size_t)c * MT + tb;
            const float w0 = sw[gch], w1 = sw[1536 + gch], w2 = sw[3072 + gch], bb = sb[gch];
            const float hb = P.in[I_HBIAS][o * 512 + c];
            const int b = n3 & 7;
            u32x2 graw[2][4]; float gxm[2][4], gxp[2][4];
#define HY_GLOAD(buf, T_) { const int ib_ = i_lo + 4 * (T_) + (n3 >> 3); _Pragma("unroll") for (int rg = 0; rg < 4; ++rg) { const int t = 32 * ib_ + 8 * rg + 4 * h3; const unsigned go = (unsigned)(b * L + t) * 2u; \
                graw[buf][rg] = *gp<const u32x2>(pg, go); gxm[buf][rg] = t > 0 ? bf2f(*gp<const bf16_t>(pg, go - 2u)) : 0.f; gxp[buf][rg] = (t + 4 < L) ? bf2f(*gp<const bf16_t>(pg, go + 8u)) : 0.f; } }
            HY_GLOAD(0, 0)
#pragma unroll
            for (int T = 0; T < NT; ++T) {
                const int ib = i_lo + 4 * T + (n3 >> 3), row = ib * 8 + b;
                if (T + 1 < NT) HY_GLOAD((T + 1) & 1, T + 1)
#pragma unroll
                for (int rg = 0; rg < 4; ++rg) {
                    const int t = 32 * ib + 8 * rg + 4 * h3;
                    const unsigned go = (unsigned)(b * L + t) * 2u;
                    const u32x2 raw = graw[T & 1][rg];
                    const float xm = gxm[T & 1][rg], xp = gxp[T & 1][rg];
                    const float x1 = bf_lo(raw.x), x2 = bf_hi(raw.x), x3 = bf_lo(raw.y), x4 = bf_hi(raw.y);
                    const float g0 = bb + w0 * xm + w1 * x1 + w2 * x2, g1 = bb + w0 * x1 + w1 * x2 + w2 * x3, g2 = bb + w0 * x2 + w1 * x3 + w2 * x4, g3 = bb + w0 * x3 + w1 * x4 + w2 * xp;
                    const int za = row * 64 + ((rg ^ ((row >> 2) & 3)) << 4) + 8 * h3;
                    const u32x2 zr = *(const LAS u32x2*)(Z + za);
                    const float z0 = g0 * (acc[T][4 * rg + 0] + hb * bf_lo(zr.x)), z1 = g1 * (acc[T][4 * rg + 1] + hb * bf_hi(zr.x)),
                                z2 = g2 * (acc[T][4 * rg + 2] + hb * bf_lo(zr.y)), z3 = g3 * (acc[T][4 * rg + 3] + hb * bf_hi(zr.y));
                    u32x2 w; w.x = pk2(z0, z1); w.y = pk2(z2, z3);
                    if (o == 0) *(LAS u32x2*)(Z + za) = w;
                    else *gp<u32x2>(py, go) = w;
                }
                __builtin_amdgcn_sched_barrier(0);
            }
#undef HY_GLOAD
        }
        __syncthreads();
    }
}

#ifndef PHMASK
#define PHMASK 0xFFFFFF
#endif
#ifndef REPMASK
#define REPMASK 0
#endif
#define PH(k) for (int rep_ = 0; rep_ < 1 + ((REPMASK >> (k)) & 1); ++rep_) if constexpr ((PHMASK >> (k)) & 1)
#define FRESH() int tid_ = threadIdx.x; asm volatile("" : "+v"(tid_)); const int tid = tid_, lane = tid & 63, wave = __builtin_amdgcn_readfirstlane(tid >> 6); \
    const int gw = bx * NWAVES + wave; unsigned char* ws = P.ws; asm volatile("" : "+s"(ws)); (void)lane; (void)gw; (void)tid
__global__ void __launch_bounds__(NTHREADS, 2) mega_fwd(Params P) {
    extern __shared__ __attribute__((aligned(16))) unsigned char lds_raw[];
    LAS unsigned char* lds = (LAS unsigned char*)lds_raw;
    cg::grid_group grid = cg::this_grid();
    const int G = gridDim.x, bx = blockIdx.x, NGW = G * NWAVES;

    PH(16) { FRESH(); for (int it = bx; it < 256; it += G) filt_raw_item((LAS float*)lds, P, it, tid); }
    PH(17) { FRESH(); for (int g = bx; g < 32; g += G) s5_mats((LAS float*)lds, P, g, tid); }
    PH(0) { FRESH();
        LAS float* scr = (LAS float*)(lds + wave * 16384);
        for (int it = gw; it < N_TRANSPOSE_ITEMS; it += NGW) transpose_job(P, it, scr, lane);
        bf16_t* XB = (bf16_t*)(ws + WS_XB);
        for (int m = gw; m < MT; m += NGW) {
            const float* xr = (m < MP ? P.in[I_XP] + (size_t)m * DM : P.in[I_XS] + (size_t)(m - MP) * DM) + 4 * lane;
#pragma unroll
            for (int j = 0; j < 4; ++j) { const f32x4 v = *(const f32x4*)(xr + 256 * j); u32x2 w; w.x = pk2(v[0], v[1]); w.y = pk2(v[2], v[3]); *(u32x2*)(XB + (size_t)m * DM + 4 * lane + 256 * j) = w; }
        }
    }
    grid.sync();
    PH(1) { FRESH(); pg8::Gemm g{(bf16_t*)(ws + WS_XB), (const bf16_t*)(ws + WS_WGU1), DM, DM, DM}; pg8::StaticOrder So; So.init(MT, 2 * FF, G, bx); pg8::EpiSwiGLU E{(bf16_t*)(ws + WS_H)};
      pg8::gemm_phase<pg8::EpiSwiGLU, pg8::StaticOrder, true>(lds, g, So, E); }
    grid.sync();
    PH(2) { FRESH(); pg8::Gemm g{(bf16_t*)(ws + WS_H), (const bf16_t*)(ws + WS_WD1), FF, FF, FF}; pg8::StaticOrder So; So.init(MT, DM, G, bx); pg8::EpiResid E{P.in[I_XP], P.in[I_XS], P.out, 0.5f};
      pg8::gemm_phase<pg8::EpiResid, pg8::StaticOrder, true>(lds, g, So, E); }
    grid.sync();
    PH(3) { FRESH(); ln_rows<false>(P.out, (bf16_t*)(ws + WS_XB), (f32x2*)(ws + WS_STATS), P.in[I_LN1G], P.in[I_LN1B], gw, NGW, lane); }
    PH(18) { FRESH(); LAS float* scr = (LAS float*)(lds + wave * 16384);
      for (int it = gw; it < N_FNORM_ITEMS; it += NGW) filt_norm_item(P, it, scr, lane); }
    grid.sync();
    PH(4) { FRESH(); pg8::Gemm g{(bf16_t*)(ws + WS_XB), (const bf16_t*)(ws + WS_WIN), DM, DM, DM}; pg8::StaticOrder So; So.init(MT, DIN, G, bx); pg8::EpiWin E{(bf16_t*)(ws + WS_H), (bf16_t*)(ws + WS_H + 160 * MiB)};
      pg8::gemm_phase<pg8::EpiWin, pg8::StaticOrder, true>(lds, g, So, E); }
    grid.sync();
    PH(5) { FRESH(); pg8::Gemm g{(bf16_t*)(ws + WS_H), (const bf16_t*)(ws + WS_WEND), 256, 512, 256}; pg8::GroupOrder So{G, bx}; pg8::EpiS E{(float*)(ws + WS_XB)};
      pg8::gemm_phase<pg8::EpiS, pg8::GroupOrder, true>(lds, g, So, E); }
    grid.sync();
    PH(6) { FRESH();
        const float* A16 = (const float*)(ws + WS_SCAN); const float* S = (const float*)(ws + WS_XB); bf16_t* UEXT = (bf16_t*)(ws + WS_H);
        for (int id = wave * G + bx; id < 1024; id += NGW) {
            const int ty = id >> 9, rest = id & 511, b = rest >> 6, g = (rest >> 1) & 31, dir = rest & 1;
            const int NC = ty ? 128 : 512, cbase = ty ? 4096 + b * 128 : b * 512;
            const float ar = A16[((g * 2 + dir) * 64 + lane) * 2], ai = A16[((g * 2 + dir) * 64 + lane) * 2 + 1];
            const f32x2* Sp = (const f32x2*)(S + (size_t)(g * NCHUNK + cbase) * 256 + dir * 128) + lane;
            unsigned* Hp = (unsigned*)(UEXT + (size_t)(g * NCHUNK + cbase) * 512 + 256 + dir * 128) + lane;
            float hr = 0.f, hi = 0.f;
            f32x2 sa[16], sb[16];
#define SC_LOAD(buf, c0_) _Pragma("unroll") for (int k = 0; k < 16; ++k) { const int ci = dir ? NC - 1 - ((c0_) + k) : (c0_) + k; buf[k] = Sp[(size_t)ci * 128]; }
#define SC_STEP(buf, c0_) _Pragma("unroll") for (int k = 0; k < 16; ++k) { const int ci = dir ? NC - 1 - ((c0_) + k) : (c0_) + k; Hp[(size_t)ci * 256] = pk2(hr, hi); \
                const float nr = ar * hr - ai * hi + buf[k][0], ni = ar * hi + ai * hr + buf[k][1]; hr = nr; hi = ni; }
            SC_LOAD(sa, 0)
            for (int c0 = 0; c0 < NC; c0 += 32) {
                SC_LOAD(sb, c0 + 16)
                SC_STEP(sa, c0)
                if (c0 + 32 < NC) { SC_LOAD(sa, c0 + 32) }
                SC_STEP(sb, c0 + 16)
            }
#undef SC_LOAD
#undef SC_STEP
        }
    }
    grid.sync();
    PH(7) { FRESH(); pg8::Gemm g{(bf16_t*)(ws + WS_H), (const bf16_t*)(ws + WS_WMAT), 512, 512, 512}; pg8::GroupOrder So{G, bx}; pg8::EpiY E{(bf16_t*)(ws + WS_XB)};
      pg8::gemm_phase<pg8::EpiY, pg8::GroupOrder, true>(lds, g, So, E); }
    grid.sync();
    PH(8) { FRESH(); pg8::Gemm g{(bf16_t*)(ws + WS_XB), (const bf16_t*)(ws + WS_WGLU), 512, 512, 512}; pg8::StaticOrder So; So.init(MT, 512, G, bx); pg8::EpiGLU E{(bf16_t*)(ws + WS_XB), P.in[I_GLUB], (bf16_t*)(ws + WS_XB + 80 * MiB)};
      pg8::gemm_phase<pg8::EpiGLU, pg8::StaticOrder, true>(lds, g, So, E); }
    PH(9) {
#pragma unroll 1
        for (int u = bx; u < 512; u += G) hyena_unit<256>(lds, P, u, 0);
#pragma unroll 1
        for (int u = bx; u < 512; u += G) hyena_unit<64>(lds, P, u, 1);
    }
    grid.sync();
    PH(10) { FRESH();
        const float* sng = P.in[I_SNG]; const float* hng = P.in[I_HNG];
        const bf16_t* YHY = (const bf16_t*)(ws + WS_YHY); const bf16_t* YSSM = (const bf16_t*)(ws + WS_XB + 80 * MiB); bf16_t* MIXED = (bf16_t*)(ws + WS_H);
        LAS unsigned* tile = (LAS unsigned*)lds;
        for (int tl = bx; tl < MT / 64; tl += G) {
            const int tok0 = tl * 64;
            for (int ci = tid; ci < 512 * 8; ci += NTHREADS) { const int c = ci >> 3, q = ci & 7; const u32x4 v = *(const u32x4*)(YHY + (size_t)c * MT + tok0 + q * 8);
                tile[c * 33 + q * 4 + 0] = v.x; tile[c * 33 + q * 4 + 1] = v.y; tile[c * 33 + q * 4 + 2] = v.z; tile[c * 33 + q * 4 + 3] = v.w; }
            for (int r = 0; r < 8; ++r) { const int tok = tok0 + wave * 8 + r;
                const u32x4 v = *(const u32x4*)(YSSM + (size_t)tok * 512 + 8 * lane);
                float x[8] = {bf_lo(v.x), bf_hi(v.x), bf_lo(v.y), bf_hi(v.y), bf_lo(v.z), bf_hi(v.z), bf_lo(v.w), bf_hi(v.w)}; float ss = 0.f;
#pragma unroll
                for (int e = 0; e < 8; ++e) ss += x[e] * x[e];
                const float sc = 1.f / sqrtf(wave_sum(ss) * (1.f / 512.f) + RMS_EPS);
                const f32x4 g0 = *(const f32x4*)(sng + 8 * lane), g1 = *(const f32x4*)(sng + 8 * lane + 4);
                u32x4 w; w.x = pk2(x[0] * sc * g0[0], x[1] * sc * g0[1]); w.y = pk2(x[2] * sc * g0[2], x[3] * sc * g0[3]); w.z = pk2(x[4] * sc * g1[0], x[5] * sc * g1[1]); w.w = pk2(x[6] * sc * g1[2], x[7] * sc * g1[3]);
                *(u32x4*)(MIXED + (size_t)tok * DM + 8 * lane) = w; }
            __syncthreads();
            for (int r = 0; r < 4; ++r) { const int tp = wave * 4 + r; float xa[8], xb[8], sa = 0.f, sb2 = 0.f;
#pragma unroll
                for (int k = 0; k < 8; ++k) { const unsigned v = tile[(lane + 64 * k) * 33 + tp]; xa[k] = bf_lo(v); xb[k] = bf_hi(v); sa += xa[k] * xa[k]; sb2 += xb[k] * xb[k]; }
                const float sca = 1.f / sqrtf(wave_sum(sa) * (1.f / 512.f) + RMS_EPS), scb = 1.f / sqrtf(wave_sum(sb2) * (1.f / 512.f) + RMS_EPS);
                bf16_t* oa = MIXED + (size_t)(tok0 + 2 * tp) * DM + 512; bf16_t* ob = oa + DM;
#pragma unroll
                for (int k = 0; k < 8; ++k) { const float gg = hng[lane + 64 * k]; const unsigned pr = pk2(xa[k] * sca * gg, xb[k] * scb * gg); oa[lane + 64 * k] = (bf16_t)(pr & 0xffffu); ob[lane + 64 * k] = (bf16_t)(pr >> 16); } }
            __syncthreads();
        }
    }
    grid.sync();
    PH(11) { FRESH(); pg8::Gemm g{(bf16_t*)(ws + WS_H), (const bf16_t*)(ws + WS_WOUT), DM, DM, DM}; pg8::StaticOrder So; So.init(MT, DM, G, bx); pg8::EpiResidLN E{P.out, (const f32x2*)(ws + WS_STATS), P.in[I_LN1G], P.in[I_LN1B], 1.0f};
      pg8::gemm_phase<pg8::EpiResidLN, pg8::StaticOrder, true>(lds, g, So, E); }
    grid.sync();
    PH(12) { FRESH(); ln_rows<false>(P.out, (bf16_t*)(ws + WS_XB), (f32x2*)(ws + WS_STATS) + MT, P.in[I_LN2G], P.in[I_LN2B], gw, NGW, lane); }
    grid.sync();
    PH(13) { FRESH(); pg8::Gemm g{(bf16_t*)(ws + WS_XB), (const bf16_t*)(ws + WS_WGU2), DM, DM, DM}; pg8::StaticOrder So; So.init(MT, 2 * FF, G, bx); pg8::EpiSwiGLU E{(bf16_t*)(ws + WS_H)};
      pg8::gemm_phase<pg8::EpiSwiGLU, pg8::StaticOrder, true>(lds, g, So, E); }
    grid.sync();
    PH(14) { FRESH(); pg8::Gemm g{(bf16_t*)(ws + WS_H), (const bf16_t*)(ws + WS_WD2), FF, FF, FF}; pg8::StaticOrder So; So.init(MT, DM, G, bx); pg8::EpiResidLN E{P.out, (const f32x2*)(ws + WS_STATS) + MT, P.in[I_LN2G], P.in[I_LN2B], 0.5f};
      pg8::gemm_phase<pg8::EpiResidLN, pg8::StaticOrder, true>(lds, g, So, E); }
    grid.sync();
    PH(15) { FRESH(); ln_rows<true>(P.out, nullptr, nullptr, P.in[I_LN3G], P.in[I_LN3B], gw, NGW, lane); }
}

extern "C" void kernel_launch(void* const* d_in, const int* in_sizes, int n_in, void* d_out, int out_size, void* d_ws, size_t ws_size, hipStream_t stream) {
    static int grid = 0;
    if (grid == 0) {
        if (n_in != 38 || out_size != MT * DM || ws_size < WS_END) { fprintf(stderr, "kernel_launch: unexpected problem: n_in %d out %d ws %zu (need %zu)\n", n_in, out_size, ws_size, (size_t)WS_END); grid = -1; return; }
        int dev = 0, cus = 0, per_cu = 0;
        hipGetDevice(&dev);
        hipDeviceGetAttribute(&cus, hipDeviceAttributeMultiprocessorCount, dev);
        hipFuncSetAttribute((const void*)mega_fwd, hipFuncAttributeMaxDynamicSharedMemorySize, LDS_BYTES);
        hipOccupancyMaxActiveBlocksPerMultiprocessor(&per_cu, (const void*)mega_fwd, NTHREADS, LDS_BYTES);
        if (per_cu < 1) { fprintf(stderr, "kernel_launch: occupancy query says %d blocks per CU\n", per_cu); per_cu = 1; }
        (void)hipGetLastError();
        grid = cus * per_cu;
        fprintf(stderr, "kernel_launch: grid %d (cus %d x %d)\n", grid, cus, per_cu);
    }
    if (grid < 0) return;
    Params p{};
    for (int i = 0; i < 38; ++i) p.in[i] = (const float*)d_in[i];
    p.out = (float*)d_out; p.ws = (unsigned char*)d_ws;
    void* args[] = {&p};
    hipError_t e = hipLaunchCooperativeKernel((const void*)mega_fwd, dim3(grid), dim3(NTHREADS), args, LDS_BYTES, stream);
    if (e != hipSuccess) fprintf(stderr, "cooperative launch failed: %s (grid %d)\n", hipGetErrorString(e), grid);
}
```
